# Optimizing an MI355X kernel written in HIP

```python
import math
import jax, jax.numpy as jnp
from jax import lax
import numpy as np

D_MODEL = 1024
BATCH = 8
SEQ = 8192
DEPTH = 2

N_A_LAYERS = DEPTH // 2
N_B_LAYERS = DEPTH - N_A_LAYERS

A_HEADS = 8
A_HEAD_DIM = 64
A_INNER = A_HEADS * 2 * A_HEAD_DIM
B_HEADS = 16
B_KV_HEADS = 2
B_HEAD_DIM = 64
B_GROUP = B_HEADS // B_KV_HEADS
B_INNER = B_HEADS * B_HEAD_DIM
WINDOW = 128
Q_BLOCK = 128
EPS = 1e-6
ADA_STD = 0.02

kernel_name = "yoco_diffattn_swa_sink_hybrid"


def rms_norm(x, g):
    x32 = x.astype(jnp.float32)
    y = x32 * lax.rsqrt(jnp.mean(x32 * x32, axis=-1, keepdims=True) + EPS)
    return (y * g.astype(jnp.float32)).astype(x.dtype)


def alibi_slopes(n_heads):
    return jnp.asarray(np.array([2.0 ** (-8.0 * (h + 1) / n_heads) for h in range(n_heads)], dtype=np.float32))


def ada_modulation(c, w, b, n_chunks):
    m = jax.nn.silu(c) @ w + b
    return jnp.split(m[:, None, :], n_chunks, axis=-1)


def diff_causal_attention(q, k, v, lam, slopes):
    bsz, seq = q.shape[0], q.shape[1]
    nb = seq // Q_BLOCK
    scale = A_HEAD_DIM ** -0.5
    qb = jnp.moveaxis(q.reshape(bsz, nb, Q_BLOCK, 2 * A_HEADS, A_HEAD_DIM), 1, 0)
    kpos = jnp.arange(seq)
    sub_slopes = jnp.repeat(slopes, 2)[:, None, None]
    lam = lam.astype(jnp.float32)

    def block(args):
        qi, blk = args
        qpos = blk * Q_BLOCK + jnp.arange(Q_BLOCK)
        dist = (qpos[:, None] - kpos[None, :]).astype(jnp.float32)
        s = jnp.einsum('bqhd,bkhd->bhqk', qi, k).astype(jnp.float32) * scale - sub_slopes * dist
        s = jnp.where(dist >= 0, s, -jnp.inf)
        p = jax.nn.softmax(s, axis=-1).reshape(bsz, A_HEADS, 2, Q_BLOCK, seq)
        a = (p[:, :, 0] - lam * p[:, :, 1]).astype(v.dtype)
        return jnp.einsum('bhqk,bkhe->bqhe', a, v)

    o = lax.map(block, (qb, jnp.arange(nb)))
    return jnp.moveaxis(o, 0, 1).reshape(bsz, seq, A_HEADS, 2 * A_HEAD_DIM)


def sliding_window_sink_attention(q, k, v, sinks, slopes):
    bsz, seq = q.shape[0], q.shape[1]
    nb = seq // WINDOW
    scale = B_HEAD_DIM ** -0.5
    qb = q.reshape(bsz, nb, WINDOW, B_KV_HEADS, B_GROUP, B_HEAD_DIM)

    def band(t):
        tb = t.reshape(bsz, nb, WINDOW, B_KV_HEADS, B_HEAD_DIM)
        prev = jnp.concatenate([jnp.zeros_like(tb[:, :1]), tb[:, :-1]], axis=1)
        return jnp.concatenate([prev, tb], axis=2)

    kw, vw = band(k), band(v)
    s = jnp.einsum('bnqkgd,bnskd->bnkgqs', qb, kw).astype(jnp.float32) * scale
    dist = jnp.arange(WINDOW)[:, None] - jnp.arange(2 * WINDOW)[None, :] + WINDOW
    kpos = jnp.arange(nb)[:, None] * WINDOW + jnp.arange(2 * WINDOW)[None, :] - WINDOW
    valid = (dist >= 0) & (dist < WINDOW) & (kpos[:, None, :] >= 0)
    s = s - slopes.reshape(B_KV_HEADS, B_GROUP, 1, 1) * dist.astype(jnp.float32)
    s = jnp.where(valid[:, None, None], s, -jnp.inf)
    sink = sinks.astype(jnp.float32).reshape(1, 1, B_KV_HEADS, B_GROUP, 1)
    m = jnp.maximum(jnp.max(s, axis=-1), sink)
    e = jnp.exp(s - m[..., None])
    p = e / (jnp.sum(e, axis=-1) + jnp.exp(sink - m))[..., None]
    o = jnp.einsum('bnkgqs,bnskd->bnqkgd', p.astype(v.dtype), vw)
    return o.reshape(bsz, seq, B_HEADS, B_HEAD_DIM)


def setup_inputs(seed: int = 0) -> dict:
    key = jax.random.key(seed)
    ks = iter(jax.random.split(key, 32))
    nrm = lambda shape, std: std * jax.random.normal(next(ks), shape, dtype=jnp.float32)
    gain = lambda shape: 1.0 + nrm(shape, 0.02)
    d = D_MODEL
    kv_width = 2 * B_KV_HEADS * B_HEAD_DIM
    return {
        "x": nrm((BATCH, SEQ, d), 1.0),
        "c": nrm((BATCH, d), 1.0),
        "a_norm_g": gain((N_A_LAYERS, d)),
        "a_ada_w": nrm((N_A_LAYERS, d, 3 * d), ADA_STD),
        "a_ada_b": nrm((N_A_LAYERS, 3 * d), 0.02),
        "a_w_in": nrm((N_A_LAYERS, d, 4 * A_INNER), d ** -0.5),
        "a_q_norm_g": gain((N_A_LAYERS, A_HEAD_DIM)),
        "a_k_norm_g": gain((N_A_LAYERS, A_HEAD_DIM)),
        "a_lambda_q1": nrm((N_A_LAYERS, A_HEAD_DIM), 0.1),
        "a_lambda_k1": nrm((N_A_LAYERS, A_HEAD_DIM), 0.1),
        "a_lambda_q2": nrm((N_A_LAYERS, A_HEAD_DIM), 0.1),
        "a_lambda_k2": nrm((N_A_LAYERS, A_HEAD_DIM), 0.1),
        "a_subln_g": gain((N_A_LAYERS, 2 * A_HEAD_DIM)),
        "a_w_out": nrm((N_A_LAYERS, A_INNER, d), A_INNER ** -0.5),
        "kv_norm_g": gain((d,)),
        "kv_ada_w": nrm((d, 2 * d), ADA_STD),
        "kv_ada_b": nrm((2 * d,), 0.02),
        "w_kv": nrm((d, kv_width), d ** -0.5),
        "kv_k_norm_g": gain((B_HEAD_DIM,)),
        "b_norm_g": gain((N_B_LAYERS, d)),
        "b_ada_w": nrm((N_B_LAYERS, d, 3 * d), ADA_STD),
        "b_ada_b": nrm((N_B_LAYERS, 3 * d), 0.02),
        "b_w_in": nrm((N_B_LAYERS, d, 2 * B_INNER), d ** -0.5),
        "b_q_norm_g": gain((N_B_LAYERS, B_HEAD_DIM)),
        "b_sinks": nrm((N_B_LAYERS, B_HEADS), 0.5),
        "b_w_out": nrm((N_B_LAYERS, B_INNER, d), B_INNER ** -0.5),
    }


def reference(x, c, a_norm_g, a_ada_w, a_ada_b, a_w_in, a_q_norm_g, a_k_norm_g,
              a_lambda_q1, a_lambda_k1, a_lambda_q2, a_lambda_k2, a_subln_g, a_w_out,
              kv_norm_g, kv_ada_w, kv_ada_b, w_kv, kv_k_norm_g,
              b_norm_g, b_ada_w, b_ada_b, b_w_in, b_q_norm_g, b_sinks, b_w_out):
    bsz, seq, _ = x.shape
    slopes_a = alibi_slopes(A_HEADS)
    slopes_b = alibi_slopes(B_HEADS)
    h = x
    k_s = v_s = None
    for layer in range(DEPTH):
        if layer < N_A_LAYERS:
            l = layer
            shift, scale, gate = ada_modulation(c, a_ada_w[l], a_ada_b[l], 3)
            u = rms_norm(h, a_norm_g[l]) * (1 + scale) + shift
            q, k, v, z = jnp.split(u @ a_w_in[l], 4, axis=-1)
            q = rms_norm(q.reshape(bsz, seq, 2 * A_HEADS, A_HEAD_DIM), a_q_norm_g[l])
            k = rms_norm(k.reshape(bsz, seq, 2 * A_HEADS, A_HEAD_DIM), a_k_norm_g[l])
            v = v.reshape(bsz, seq, A_HEADS, 2 * A_HEAD_DIM)
            lambda_init = 0.8 - 0.6 * math.exp(-0.3 * l)
            lam = (jnp.exp(jnp.sum(a_lambda_q1[l].astype(jnp.float32) * a_lambda_k1[l].astype(jnp.float32)))
                   - jnp.exp(jnp.sum(a_lambda_q2[l].astype(jnp.float32) * a_lambda_k2[l].astype(jnp.float32)))
                   + lambda_init)
            o = diff_causal_attention(q, k, v, lam, slopes_a)
            o = rms_norm(o, a_subln_g[l]) * (1.0 - lambda_init)
            o = o.reshape(bsz, seq, A_INNER) * jax.nn.silu(z)
            h = h + gate * (o @ a_w_out[l])
            if layer == N_A_LAYERS - 1:
                kv_shift, kv_scale = ada_modulation(c, kv_ada_w, kv_ada_b, 2)
                ukv = rms_norm(h, kv_norm_g) * (1 + kv_scale) + kv_shift
                k_s, v_s = jnp.split(ukv @ w_kv, 2, axis=-1)
                k_s = rms_norm(k_s.reshape(bsz, seq, B_KV_HEADS, B_HEAD_DIM), kv_k_norm_g)
                v_s = v_s.reshape(bsz, seq, B_KV_HEADS, B_HEAD_DIM)
        else:
            l = layer - N_A_LAYERS
            shift, scale, gate = ada_modulation(c, b_ada_w[l], b_ada_b[l], 3)
            u = rms_norm(h, b_norm_g[l]) * (1 + scale) + shift
            q, z = jnp.split(u @ b_w_in[l], 2, axis=-1)
            q = rms_norm(q.reshape(bsz, seq, B_HEADS, B_HEAD_DIM), b_q_norm_g[l])
            o = sliding_window_sink_attention(q, k_s, v_s, b_sinks[l], slopes_b)
            o = o.reshape(bsz, seq, B_INNER) * jax.nn.silu(z)
            h = h + gate * (o @ b_w_out[l])
    return h
```

```cpp
#include <hip/hip_runtime.h>
#include <hip/hip_cooperative_groups.h>
#include <cstdio>
#include <cstdint>
namespace cg = cooperative_groups;
namespace pg8 {
#define PG8_LAS __attribute__((address_space(3)))
typedef unsigned short bf16_t;
typedef short bf16x8 __attribute__((ext_vector_type(8)));
typedef float f32x4 __attribute__((ext_vector_type(4)));
typedef unsigned u32x4 __attribute__((ext_vector_type(4)));
constexpr int BM = 256, BK = 64, HALF = 128, HTB = HALF * BK * 2  , STAGE_BYTES = 8 * HTB, NXCD = 8, WGM = 8;

__host__ __device__ __forceinline__ int lds_byte(int r, int c) { const int st = (r >> 4) * 2 + (c >> 5), rr = r & 15, cc = c & 31, ob = rr * 64 + cc * 2; return st * 1024 + (ob ^ (((ob >> 9) & 1) << 5)); }
__host__ __device__ __forceinline__ void stage_rc(int b, int& R, int& C) { const int st = b / 1024, sb = b % 1024, swz = sb ^ (((sb >> 9) & 1) << 5); R = (st >> 1) * 16 + swz / 64; C = (st & 1) * 32 + (swz % 64) / 2; }
__host__ __device__ __forceinline__ int perm32(int rho) { const int n = rho >> 4, i = rho & 15; return 8 * (i >> 2) + 4 * n + (i & 3); }

struct Unit { int pm, pn; };
struct Gemm { const bf16_t* A; const bf16_t* Bt; int M, N, K; size_t bstride = 0; };

struct StaticOrder {
    int nM, nN, nwg, G, c;
    __host__ __device__ void init(int M, int N, int G_, int c_) { nM = M / BM; nN = N / BM; nwg = nM * nN; G = G_; c = c_; }
    __host__ __device__ bool next(int i, Unit& u) const {
        const long L = (long)i * G + c; if (L >= nwg) return false;
        int wgid = (int)L; { const int q = nwg / NXCD, r = nwg % NXCD, xcd = wgid % NXCD, off = wgid / NXCD; wgid = (xcd < r ? xcd * (q + 1) : r * (q + 1) + (xcd - r) * q) + off; }
        const int nig = WGM * nN, gid = wgid / nig, fm = gid * WGM, gsz = (nM - fm) < WGM ? (nM - fm) : WGM;
        u.pm = fm + ((wgid % nig) % gsz); u.pn = (wgid % nig) / gsz; return true;
    }
    __device__ __forceinline__ void a_ready(const Unit&) const {}
    __device__ __forceinline__ void done(const Unit&) const {}
};

__device__ __forceinline__ unsigned cvt_pk_bf16(float lo, float hi) { unsigned r; asm volatile("v_cvt_pk_bf16_f32 %0, %1, %2" : "=v"(r) : "v"(lo), "v"(hi)); return r; }
typedef unsigned u32x4e __attribute__((ext_vector_type(4)));
constexpr float QK_C2 = 0.125f * 1.4426950408889634f;
struct EpiProj {
    static constexpr bool PERM = true, AFTER_DRAIN = false;
    bf16_t* out0; size_t tstride;
    const float* gtab;
    int hpt, ldo;
    int modes;
    const float* rstd = nullptr; const float* cbias = nullptr; int cb_ld = 0;
    __device__ __forceinline__ void operator()(const f32x4 (&acc)[2][2][4][2], const Unit& u, int wr, int wc, int fr, int fq) const {
        const int head = u.pn * 4 + wc, ty = head / hpt, hh = head - ty * hpt;
        bf16_t* base = out0 + (size_t)ty * tstride;
        const int mode = (modes >> (8 * ty)) & 15, lay = (modes >> (8 * ty + 4)) & 15;
        const float* g = gtab + 64 * ty;
        int row0 = u.pm * BM + wr * 64 + fr, colh = hh * 64 + 8 * fq, ldo = this->ldo;
        const int trow0 = row0;
        f32x4 cbv[2][2];
#pragma unroll
        for (int bj = 0; bj < 2; ++bj)
#pragma unroll
            for (int n = 0; n < 2; ++n) cbv[bj][n] = cbias ? *(const f32x4*)(cbias + (size_t)(u.pm >> 5) * cb_ld + head * 64 + 32 * bj + 8 * fq + 4 * n) : (f32x4){0.f, 0.f, 0.f, 0.f};
        if (lay == 1) { const int bb = row0 >> 13; row0 = (bb * hpt + hh) * 8192 + (row0 & 8191); colh = 8 * fq; ldo = 64; }
        else if (lay == 2) { const int bb = row0 >> 13; row0 = (bb * (hpt >> 1) + (hh >> 1)) * 8192 + (row0 & 8191); colh = (hh & 1) * 64 + 8 * fq; ldo = 128; }
        if (mode == 1 || mode == 2) {
            const float gs = mode == 2 ? QK_C2 : 1.0f;
            f32x4 gv[2][2];
#pragma unroll
            for (int bj = 0; bj < 2; ++bj)
#pragma unroll
                for (int n = 0; n < 2; ++n) gv[bj][n] = *(const f32x4*)(g + 32 * bj + 8 * fq + 4 * n) * gs;
#pragma unroll
            for (int ai = 0; ai < 2; ++ai)
#pragma unroll
                for (int m = 0; m < 4; ++m) {
                    const float rs_ = rstd ? rstd[trow0 + ai * HALF + m * 16] : 1.0f;
                    f32x4 xv[2][2];
                    float ss = 0.f;
#pragma unroll
                    for (int bj = 0; bj < 2; ++bj)
#pragma unroll
                        for (int n = 0; n < 2; ++n) { const f32x4 x = acc[ai][bj][m][n] * rs_ + cbv[bj][n]; xv[bj][n] = x; ss += (x[0] * x[0] + x[1] * x[1]) + (x[2] * x[2] + x[3] * x[3]); }
                    { auto r16 = __builtin_amdgcn_permlane16_swap(__float_as_uint(ss), __float_as_uint(ss), false, false); ss = __uint_as_float(r16[0]) + __uint_as_float(r16[1]);
                      auto r32 = __builtin_amdgcn_permlane32_swap(__float_as_uint(ss), __float_as_uint(ss), false, false); ss = __uint_as_float(r32[0]) + __uint_as_float(r32[1]); }
                    const float rstd_h = rsqrtf(ss * (1.0f / 64.0f) + 1e-6f);
                    bf16_t* rowp = base + (size_t)(row0 + ai * HALF + m * 16) * ldo + colh;
#pragma unroll
                    for (int bj = 0; bj < 2; ++bj) { const f32x4 v0 = xv[bj][0] * rstd_h * gv[bj][0], v1 = xv[bj][1] * rstd_h * gv[bj][1];
                        u32x4e w; w.x = cvt_pk_bf16(v0[0], v0[1]); w.y = cvt_pk_bf16(v0[2], v0[3]); w.z = cvt_pk_bf16(v1[0], v1[1]); w.w = cvt_pk_bf16(v1[2], v1[3]);
                        *(u32x4e*)(rowp + bj * 32) = w; }
                }
        } else {
#pragma unroll
            for (int ai = 0; ai < 2; ++ai)
#pragma unroll
                for (int m = 0; m < 4; ++m) {
                    bf16_t* rowp = base + (size_t)(row0 + ai * HALF + m * 16) * ldo + colh;
                    const float rs_ = rstd ? rstd[trow0 + ai * HALF + m * 16] : 1.0f;
#pragma unroll
                    for (int bj = 0; bj < 2; ++bj) { f32x4 v0 = acc[ai][bj][m][0] * rs_ + cbv[bj][0], v1 = acc[ai][bj][m][1] * rs_ + cbv[bj][1];
                        if (mode == 3) {
#pragma unroll
                            for (int e = 0; e < 4; ++e) { v0[e] = v0[e] * __builtin_amdgcn_rcpf(1.0f + __expf(-v0[e])); v1[e] = v1[e] * __builtin_amdgcn_rcpf(1.0f + __expf(-v1[e])); } }
                        u32x4e w; w.x = cvt_pk_bf16(v0[0], v0[1]); w.y = cvt_pk_bf16(v0[2], v0[3]); w.z = cvt_pk_bf16(v1[0], v1[1]); w.w = cvt_pk_bf16(v1[2], v1[3]);
                        *(u32x4e*)(rowp + bj * 32) = w; }
                }
        }
    }
};
template <bool BASE_BF16, bool OUT_BF16> struct EpiRes {
    static constexpr bool PERM = true, AFTER_DRAIN = false;
    const void* base; void* out; const float* gate; int ldg;
    __device__ __forceinline__ void operator()(const f32x4 (&acc)[2][2][4][2], const Unit& u, int wr, int wc, int fr, int fq) const {
        const int col = (u.pn * 4 + wc) * 64 + 8 * fq, row0 = u.pm * BM + wr * 64 + fr;
        const float* gp = gate + (size_t)(u.pm >> 5) * ldg + col;
        f32x4 gv[2][2];
#pragma unroll
        for (int bj = 0; bj < 2; ++bj)
#pragma unroll
            for (int n = 0; n < 2; ++n) gv[bj][n] = *(const f32x4*)(gp + 32 * bj + 4 * n);
#pragma unroll
        for (int ai = 0; ai < 2; ++ai) {
            f32x4 bs[4][2][2];
#pragma unroll
            for (int m = 0; m < 4; ++m) { const size_t off = (size_t)(row0 + ai * HALF + m * 16) * 1024 + col;
#pragma unroll
                for (int bj = 0; bj < 2; ++bj) {
                    if (BASE_BF16) { const u32x4e w = *(const u32x4e*)((const bf16_t*)base + off + 32 * bj);
                        bs[m][bj][0] = (f32x4){__uint_as_float(w.x << 16), __uint_as_float(w.x & 0xffff0000u), __uint_as_float(w.y << 16), __uint_as_float(w.y & 0xffff0000u)};
                        bs[m][bj][1] = (f32x4){__uint_as_float(w.z << 16), __uint_as_float(w.z & 0xffff0000u), __uint_as_float(w.w << 16), __uint_as_float(w.w & 0xffff0000u)}; }
                    else { bs[m][bj][0] = *(const f32x4*)((const float*)base + off + 32 * bj); bs[m][bj][1] = *(const f32x4*)((const float*)base + off + 32 * bj + 4); } } }
            asm volatile("" ::: "memory");
#pragma unroll
            for (int m = 0; m < 4; ++m) { const size_t off = (size_t)(row0 + ai * HALF + m * 16) * 1024 + col;
#pragma unroll
                for (int bj = 0; bj < 2; ++bj) { const f32x4 v0 = bs[m][bj][0] + gv[bj][0] * acc[ai][bj][m][0], v1 = bs[m][bj][1] + gv[bj][1] * acc[ai][bj][m][1];
                    if (OUT_BF16) { u32x4e w; w.x = cvt_pk_bf16(v0[0], v0[1]); w.y = cvt_pk_bf16(v0[2], v0[3]); w.z = cvt_pk_bf16(v1[0], v1[1]); w.w = cvt_pk_bf16(v1[2], v1[3]); *(u32x4e*)((bf16_t*)out + off + 32 * bj) = w; }
                    else { *(f32x4*)((float*)out + off + 32 * bj) = v0; *(f32x4*)((float*)out + off + 32 * bj + 4) = v1; } } }
            asm volatile("" ::: "memory");
        }
    }
};
template <class Epi, class Sched, bool ALIGN_EPI = false, bool SP2 = false>
__device__ __forceinline__ void gemm_phase(PG8_LAS unsigned char* lds, const Gemm g, const Sched& S, const Epi& E, const int wave_) {
    int tid; { int l_; asm volatile("v_mbcnt_lo_u32_b32 %0, -1, 0\n\tv_mbcnt_hi_u32_b32 %0, -1, %0" : "=v"(l_)); tid = wave_ * 64 + l_; }
    const int wid = __builtin_amdgcn_readfirstlane(tid >> 6), lane = tid & 63, wr = wid >> 2, wc = wid & 3, fr = lane & 15, fq = lane >> 4;
    const int K = g.K, nt = K / BK;
    unsigned voffA[2], voffB[2];
#pragma unroll
    for (int i = 0; i < 2; ++i) { int R, C; stage_rc(tid * 16 + i * 8192, R, C); const int Rb = Epi::PERM ? ((R & ~31) + perm32(R & 31)) : R;
        voffA[i] = (unsigned)(R * K + C) * 2u; voffB[i] = (unsigned)(Rb * K + C) * 2u; }
    const size_t kstep = (size_t)(BK * 2);
    const size_t hstep = (size_t)HALF * K * 2;
    const size_t tstep = 2 * hstep;
    const unsigned ldsw = (unsigned)wid * 1024u;
    const int aoff = lds_byte(wr * 64 + fr, fq * 8), boff = lds_byte(wc * 32 + fr, fq * 8);
#define PG8_SA(b, h) (((b) * 2 + (h)) * HTB)
#define PG8_SB(b, h) ((4 + (b) * 2 + (h)) * HTB)
#define PG8_STAGE(bufoff, gbase, voff) do { _Pragma("unroll") for (int _i = 0; _i < 2; ++_i) \
        __builtin_amdgcn_global_load_lds((const unsigned*)((const char*)(gbase) + (voff)[_i]), (PG8_LAS unsigned*)(lds + (bufoff) + ldsw + _i * 8192), 16, 0, 0); } while (0)
#define PG8_LDA(dst, b, h) do { _Pragma("unroll") for (int m = 0; m < 4; ++m) _Pragma("unroll") for (int k = 0; k < 2; ++k) dst[m][k] = *(const PG8_LAS bf16x8*)(lds + PG8_SA(b, h) + aoff + m * 2048 + k * 1024); } while (0)
#define PG8_LDB(dst, b, h) do { _Pragma("unroll") for (int n = 0; n < 2; ++n) _Pragma("unroll") for (int k = 0; k < 2; ++k) dst[n][k] = *(const PG8_LAS bf16x8*)(lds + PG8_SB(b, h) + boff + n * 2048 + k * 1024); } while (0)
#define PG8_MMA(ai, bj, At, Bt) do { __builtin_amdgcn_s_setprio(1); _Pragma("unroll") for (int m = 0; m < 4; ++m) _Pragma("unroll") for (int n = 0; n < 2; ++n) _Pragma("unroll") for (int k = 0; k < 2; ++k) \
        acc[ai][bj][m][n] = __builtin_amdgcn_mfma_f32_16x16x32_bf16(Bt[n][k], At[m][k], acc[ai][bj][m][n], 0, 0, 0); __builtin_amdgcn_s_setprio(0); } while (0)
#define PG8_WAIT_V(n) asm volatile("s_waitcnt vmcnt(" #n ")" ::: "memory")
#define PG8_WAIT_L(n) asm volatile("s_waitcnt lgkmcnt(" #n ")" ::: "memory")
#define PG8_BAR __builtin_amdgcn_s_barrier()
#define PG8_SCHED __builtin_amdgcn_sched_barrier(0)
    Unit cur, nxt; int ui = 0;
    if (!S.next(0, cur)) return;
    f32x4 acc[2][2][4][2];
#pragma unroll
    for (int a = 0; a < 2; ++a)
#pragma unroll
        for (int b = 0; b < 2; ++b)
#pragma unroll
            for (int m = 0; m < 4; ++m)
#pragma unroll
                for (int n = 0; n < 2; ++n) acc[a][b][m][n] = (f32x4){0.f, 0.f, 0.f, 0.f};
    bf16x8 At[4][2], B0[2][2], B1[2][2];
    const char* cA = (const char*)g.A + (size_t)cur.pm * tstep; const char* cB = (const char*)g.Bt + (size_t)cur.pn * tstep + (size_t)(cur.pm >> 5) * g.bstride * 2;
    S.a_ready(cur);
    if constexpr (SP2) {
        PG8_STAGE(PG8_SB(0, 0), cB, voffB); PG8_STAGE(PG8_SB(0, 1), cB + hstep, voffB); PG8_STAGE(PG8_SA(0, 0), cA, voffA); PG8_STAGE(PG8_SA(0, 1), cA + hstep, voffA);
        if (wr == 1) PG8_BAR;
        PG8_WAIT_V(2); PG8_BAR;
        PG8_STAGE(PG8_SB(1, 0), cB + kstep, voffB); PG8_STAGE(PG8_SA(1, 0), cA + kstep, voffA); PG8_STAGE(PG8_SB(1, 1), cB + hstep + kstep, voffB);
        PG8_WAIT_V(6); PG8_BAR;
    } else {
        PG8_STAGE(PG8_SB(0, 0), cB, voffB); PG8_STAGE(PG8_SA(0, 0), cA, voffA); PG8_STAGE(PG8_SB(0, 1), cB + hstep, voffB); PG8_STAGE(PG8_SA(0, 1), cA + hstep, voffA);
        if (wr == 1) PG8_BAR;
        PG8_WAIT_V(4); PG8_BAR;
        PG8_STAGE(PG8_SB(1, 0), cB + kstep, voffB); PG8_STAGE(PG8_SA(1, 0), cA + kstep, voffA); PG8_STAGE(PG8_SB(1, 1), cB + hstep + kstep, voffB);
        PG8_WAIT_V(6); PG8_BAR;
    }
    for (;;) {
        const bool has_next = S.next(ui + 1, nxt);
        const char* nA = has_next ? (const char*)g.A + (size_t)nxt.pm * tstep : cA; const char* nB = has_next ? (const char*)g.Bt + (size_t)nxt.pn * tstep + (size_t)(nxt.pm >> 5) * g.bstride * 2 : cB;
        for (int t = 0; t < nt; t += 2) {
            const bool last = (t == nt - 2);
            const char* a1 = cA + (size_t)(t + 1) * kstep;
            const char* a2 = last ? nA : cA + (size_t)(t + 2) * kstep; const char* b2 = last ? nB : cB + (size_t)(t + 2) * kstep;
            const char* a3 = a2 + kstep; const char* b3 = b2 + kstep;
            if (last && has_next) S.a_ready(nxt);
            if constexpr (SP2) {
            PG8_LDB(B0, 0, 0); PG8_LDB(B1, 0, 1); PG8_SCHED; PG8_LDA(At, 0, 0); PG8_STAGE(PG8_SA(1, 1), a1 + hstep, voffA);
            PG8_WAIT_V(8); PG8_WAIT_L(0); PG8_BAR; PG8_MMA(0, 0, At, B0); PG8_MMA(0, 1, At, B1); PG8_BAR; PG8_SCHED;
            PG8_LDA(At, 0, 1); PG8_STAGE(PG8_SB(0, 0), b2, voffB); PG8_STAGE(PG8_SB(0, 1), b2 + hstep, voffB); PG8_STAGE(PG8_SA(0, 0), a2, voffA);
            PG8_WAIT_V(8); PG8_WAIT_L(0); PG8_BAR; PG8_MMA(1, 0, At, B0); PG8_MMA(1, 1, At, B1); PG8_BAR; PG8_SCHED;
            PG8_LDB(B0, 1, 0); PG8_LDB(B1, 1, 1); PG8_SCHED; PG8_LDA(At, 1, 0); PG8_STAGE(PG8_SA(0, 1), a2 + hstep, voffA);
            PG8_WAIT_V(8); PG8_WAIT_L(0); PG8_BAR; PG8_MMA(0, 0, At, B0); PG8_MMA(0, 1, At, B1); PG8_BAR; PG8_SCHED;
            PG8_LDA(At, 1, 1); PG8_STAGE(PG8_SB(1, 0), b3, voffB); PG8_STAGE(PG8_SB(1, 1), b3 + hstep, voffB); PG8_STAGE(PG8_SA(1, 0), a3, voffA);
            PG8_WAIT_V(8); PG8_WAIT_L(0); PG8_BAR; PG8_MMA(1, 0, At, B0); PG8_MMA(1, 1, At, B1); PG8_BAR; PG8_SCHED;
            } else {
            PG8_LDB(B0, 0, 0); PG8_SCHED; PG8_LDA(At, 0, 0); PG8_STAGE(PG8_SA(1, 1), a1 + hstep, voffA);
            PG8_WAIT_L(8); PG8_BAR; PG8_WAIT_L(0); PG8_MMA(0, 0, At, B0); PG8_BAR; PG8_SCHED;
            PG8_LDB(B1, 0, 1); PG8_STAGE(PG8_SB(0, 0), b2, voffB);
            PG8_BAR; PG8_WAIT_L(0); PG8_MMA(0, 1, At, B1); PG8_BAR;
            PG8_LDA(At, 0, 1); PG8_STAGE(PG8_SA(0, 0), a2, voffA);
            PG8_BAR; PG8_WAIT_L(0); PG8_MMA(1, 0, At, B0); PG8_BAR; PG8_SCHED;
            PG8_STAGE(PG8_SB(0, 1), b2 + hstep, voffB);
            PG8_WAIT_V(6); PG8_BAR; PG8_MMA(1, 1, At, B1); PG8_BAR;
            PG8_LDB(B0, 1, 0); PG8_SCHED; PG8_LDA(At, 1, 0); PG8_STAGE(PG8_SA(0, 1), a2 + hstep, voffA);
            PG8_WAIT_L(8); PG8_BAR; PG8_WAIT_L(0); PG8_MMA(0, 0, At, B0); PG8_BAR; PG8_SCHED;
            PG8_LDB(B1, 1, 1); PG8_STAGE(PG8_SB(1, 0), b3, voffB);
            PG8_BAR; PG8_WAIT_L(0); PG8_MMA(0, 1, At, B1); PG8_BAR;
            PG8_LDA(At, 1, 1); PG8_STAGE(PG8_SA(1, 0), a3, voffA);
            PG8_BAR; PG8_WAIT_L(0); PG8_MMA(1, 0, At, B0); PG8_BAR; PG8_SCHED;
            PG8_STAGE(PG8_SB(1, 1), b3 + hstep, voffB);
            PG8_WAIT_V(6); PG8_BAR; PG8_MMA(1, 1, At, B1); PG8_BAR;
            }
        }
        if constexpr (ALIGN_EPI) { if (wr == 0) PG8_BAR; }
        if constexpr (!Epi::AFTER_DRAIN) { E(acc, cur, wr, wc, fr, fq); S.done(cur); }
        if (!has_next) break;
#pragma unroll
        for (int a = 0; a < 2; ++a)
#pragma unroll
            for (int b = 0; b < 2; ++b)
#pragma unroll
                for (int m = 0; m < 4; ++m)
#pragma unroll
                    for (int n = 0; n < 2; ++n) acc[a][b][m][n] = (f32x4){0.f, 0.f, 0.f, 0.f};
        cur = nxt; cA = nA; cB = nB; ++ui;
        if constexpr (ALIGN_EPI) { if (wr == 1) PG8_BAR; }
    }
    PG8_WAIT_V(0);
    if constexpr (!ALIGN_EPI) { if (wr == 0) PG8_BAR; }
    PG8_BAR;
    if constexpr (Epi::AFTER_DRAIN) { E.fused(acc, cur, wr, wc, fr, fq, lds, wid, lane); S.done(cur); }
#undef PG8_SA
#undef PG8_SB
#undef PG8_STAGE
#undef PG8_LDA
#undef PG8_LDB
#undef PG8_MMA
#undef PG8_WAIT_V
#undef PG8_WAIT_L
#undef PG8_BAR
#undef PG8_SCHED
}
}
constexpr int BATCH = 8, SEQ = 8192, DM = 1024, MROWS = BATCH * SEQ;
constexpr float LOG2E = 1.4426950408889634f;
constexpr size_t MiB = 1u << 20;
constexpr size_t WS_CTL = 0, WS_MOD = 1 * MiB, WS_WINA = 2 * MiB, WS_WOUTA = 10 * MiB, WS_WKV = 12 * MiB, WS_WINB = 13 * MiB, WS_WOUTB = 17 * MiB;
constexpr size_t WS_R0 = 32 * MiB, WS_R1 = 160 * MiB, WS_R2 = 288 * MiB, WS_R3 = 416 * MiB, WS_R4 = 544 * MiB, WS_H = 672 * MiB, WS_END = 928 * MiB;
constexpr int LDS_BYTES = 147456;
constexpr int NTHREADS = 512;

#define LAS __attribute__((address_space(3)))
typedef unsigned short bf16_t;
typedef short bf16x8 __attribute__((ext_vector_type(8)));
typedef short s16x4 __attribute__((ext_vector_type(4)));
typedef float f32x4 __attribute__((ext_vector_type(4)));
typedef float f32x16 __attribute__((ext_vector_type(16)));
typedef unsigned u32x4 __attribute__((ext_vector_type(4)));
typedef unsigned u32x2 __attribute__((ext_vector_type(2)));
typedef LAS const unsigned char* lds_cptr;

__device__ __forceinline__ unsigned cvtpk(float lo, float hi) { unsigned r; asm("v_cvt_pk_bf16_f32 %0, %1, %2" : "=v"(r) : "v"(lo), "v"(hi)); return r; }
__device__ __forceinline__ float bf_lo(unsigned w) { return __uint_as_float(w << 16); }
__device__ __forceinline__ float bf_hi(unsigned w) { return __uint_as_float(w & 0xffff0000u); }
__device__ __forceinline__ float wave_sum(float v) {
#pragma unroll
    for (int o = 1; o < 64; o <<= 1) v += __shfl_xor(v, o);
    return v;
}
__device__ __forceinline__ float half_swap_max(float m) { auto rr = __builtin_amdgcn_permlane32_swap(__float_as_uint(m), __float_as_uint(m), false, false); return fmaxf(__uint_as_float(rr[0]), __uint_as_float(rr[1])); }
__device__ __forceinline__ float half_swap_sum(float m) { auto rr = __builtin_amdgcn_permlane32_swap(__float_as_uint(m), __float_as_uint(m), false, false); return __uint_as_float(rr[0]) + __uint_as_float(rr[1]); }
__device__ __forceinline__ int my_tid(int wave) { int l_; asm volatile("v_mbcnt_lo_u32_b32 %0, -1, 0\n\tv_mbcnt_hi_u32_b32 %0, -1, %0" : "=v"(l_)); return wave * 64 + l_; }
#define XB_TMO      128
#define XB_XCNT(j)  (256  + 64 * (j))
#define XB_XSUB(j)  (1280 + 64 * (j))
#define XB_XGEN(j)  (2304 + 64 * (j))
#define XB_TOP      3328
#define XB_TOPGEN   3392
#define XCD_BAR_WORDS 3456
#define XB_SPIN_CAP (1u << 23)
__device__ __forceinline__ unsigned xb_ld(unsigned* p)              { return __hip_atomic_load(p, __ATOMIC_RELAXED, __HIP_MEMORY_SCOPE_AGENT); }
__device__ __forceinline__ unsigned xb_add(unsigned* p, unsigned v) { return __hip_atomic_fetch_add(p, v, __ATOMIC_RELAXED, __HIP_MEMORY_SCOPE_AGENT); }
#define XB_SPIN(cond, bar) do { unsigned _sp = 0; while (cond) { __builtin_amdgcn_s_sleep(1); \
    if ((++_sp & 255u) == 0u) { if (xb_ld(&(bar)[XB_TMO])) break; if (_sp > XB_SPIN_CAP) { atomicAdd(&(bar)[XB_TMO], 1u); break; } } } } while (0)
__device__ __forceinline__ void grid_bar(unsigned* bar, const unsigned x, volatile LAS unsigned* st, int wave) {
    asm volatile("s_waitcnt vmcnt(0)" ::: "memory");
    __syncthreads();
    if (my_tid(wave) == 0) {
        __builtin_amdgcn_s_waitcnt(0);
        unsigned nloc = st[0], nx = st[1];
        if (nloc == 0u) {
            const unsigned G_ = gridDim.x; unsigned sum, cnt, mine, sp = 0u;
            for (;;) {
                sum = 0u; cnt = 0u; mine = 0u;
#pragma unroll
                for (unsigned jx = 0; jx < 16; ++jx) { const unsigned c_ = xb_ld(&bar[XB_XCNT(jx)]); sum += c_; cnt += (c_ > 0u) ? 1u : 0u; mine = (jx == x) ? c_ : mine; }
                if (sum == G_) break;
                __builtin_amdgcn_s_sleep(1);
                if ((++sp & 255u) == 0u) { if (xb_ld(&bar[XB_TMO])) break; if (sp > XB_SPIN_CAP) { atomicAdd(&bar[XB_TMO], 1u); break; } }
            }
            nloc = mine > 0u ? mine : 1u; nx = cnt > 0u ? cnt : 1u; st[0] = nloc; st[1] = nx;
        }
        const unsigned old = xb_add(&bar[XB_XSUB(x)], 1u);
        const unsigned gen = old / nloc;
        if (old + 1u == (gen + 1u) * nloc) {
            __builtin_amdgcn_fence(__ATOMIC_RELEASE, "agent");
            asm volatile("s_waitcnt vmcnt(0)" ::: "memory");
            const unsigned og = xb_add(&bar[XB_TOP], 1u);
            const unsigned tg = og / nx;
            if (og + 1u == (tg + 1u) * nx) xb_add(&bar[XB_TOPGEN], 1u);
            else XB_SPIN(xb_ld(&bar[XB_TOPGEN]) == tg, bar);
            __builtin_amdgcn_fence(__ATOMIC_ACQUIRE, "agent");
            xb_add(&bar[XB_XGEN(x)], 1u);
            asm volatile("s_waitcnt vmcnt(0)" ::: "memory");
        } else {
            XB_SPIN(xb_ld(&bar[XB_XGEN(x)]) == gen, bar);
            __builtin_amdgcn_fence(__ATOMIC_ACQUIRE, "agent");
            asm volatile("s_waitcnt vmcnt(0)" ::: "memory");
        }
    }
    __syncthreads();
}
__device__ __forceinline__ int crow(int r, int hi) { return (r & 3) + 8 * (r >> 2) + 4 * hi; }
__device__ __forceinline__ void glds16(const void* g, unsigned lds_base) {
    unsigned sv; asm volatile("s_mov_b32 %0, m0\n\ts_mov_b32 m0, %2\n\ts_nop 0\n\tglobal_load_lds_dwordx4 %1, off\n\ts_mov_b32 m0, %0" : "=&s"(sv) : "v"(g), "s"(lds_base) : "memory"); }
#define GLDS(g, dst) glds16((g), (unsigned)__builtin_amdgcn_readfirstlane((int)(dst)))
#define WAIT_BAR(N) asm volatile("s_waitcnt vmcnt(" #N ") lgkmcnt(0)\n\ts_barrier" ::: "memory")
#define LDS_WAIT() asm volatile("s_waitcnt lgkmcnt(0)" ::: "memory")
typedef short v4i16_t __attribute__((ext_vector_type(4)));
__device__ __forceinline__ s16x4 vtr(lds_cptr p) { return __builtin_bit_cast(s16x4, __builtin_amdgcn_ds_read_tr16_b64_v4i16((LAS v4i16_t*)p)); }
#define MFMA32(a, b, c) __builtin_amdgcn_mfma_f32_32x32x16_bf16((a), (b), (c), 0, 0, 0)

__device__ __forceinline__ void pack_p(bf16x8 (&pf)[4], const f32x16& p0, const f32x16& p1) {
    u32x4 w;
    w.x = cvtpk(p0[0], p0[1]); w.y = cvtpk(p0[2], p0[3]); w.z = cvtpk(p0[4], p0[5]); w.w = cvtpk(p0[6], p0[7]); pf[0] = __builtin_bit_cast(bf16x8, w);
    w.x = cvtpk(p0[8], p0[9]); w.y = cvtpk(p0[10], p0[11]); w.z = cvtpk(p0[12], p0[13]); w.w = cvtpk(p0[14], p0[15]); pf[1] = __builtin_bit_cast(bf16x8, w);
    w.x = cvtpk(p1[0], p1[1]); w.y = cvtpk(p1[2], p1[3]); w.z = cvtpk(p1[4], p1[5]); w.w = cvtpk(p1[6], p1[7]); pf[2] = __builtin_bit_cast(bf16x8, w);
    w.x = cvtpk(p1[8], p1[9]); w.y = cvtpk(p1[10], p1[11]); w.z = cvtpk(p1[12], p1[13]); w.w = cvtpk(p1[14], p1[15]); pf[3] = __builtin_bit_cast(bf16x8, w);
}
constexpr int ASLOT = 32768;
__device__ __forceinline__ void attnA_unit(const int wave_, LAS unsigned char* lds, unsigned lds0, const int s0, const int pre, LAS int* nextw, const LAS int* cuts, const LAS int* utab, unsigned* qheads, const int xcc, bf16x8 (&qio)[4],
                                           int b, int h, int qb, int t_lo, float smax2,
                                           const bf16_t* QA, const bf16_t* KA, const bf16_t* VA, const bf16_t* ZA, bf16_t* OA, const float* subg, float lam) {
    const int tid = my_tid(wave_);
    const int lane = tid & 63, r32 = lane & 31, hi = lane >> 5;
    const int wid = wave_, j = wid >> 2, wq = wid & 3;
    const int q0 = qb * 128, NT = (q0 + 128) / 64 - t_lo;
    const size_t rowbase = (size_t)b * SEQ;
    const int qloc = 32 * wq + r32, qpos = q0 + qloc;
    const float slope2 = exp2f(-(float)(h + 1)) * LOG2E;
    bf16x8 qf[4];
    if (pre) {
#pragma unroll
        for (int d0 = 0; d0 < 4; ++d0) qf[d0] = qio[d0];
    } else { const bf16_t* Qw = QA + (rowbase + qpos) * 1024 + (2 * h + j) * 64 + hi * 8;
#pragma unroll
      for (int d0 = 0; d0 < 4; ++d0) qf[d0] = *(const bf16x8*)(Qw + d0 * 16); }
    const int krow = 8 * wid + (lane >> 3), kch = (lane & 7) ^ ((krow >> 1) & 7);
    const bf16_t* ksrc0 = KA + ((size_t)(b * 16 + 2 * h) * SEQ + krow) * 64 + kch * 8;
    const int pva = 2 * wid, pvb = 2 * wid + 1, vch = (lane & 15) ^ (((lane >> 4) & 3) << 2);
    const bf16_t* vsrcA = VA + ((size_t)(b * 8 + h) * SEQ + 4 * pva + (lane >> 4)) * 128 + vch * 8;
    const bf16_t* vsrcB = vsrcA + 4 * 128;
    const int klane = krow * 64 + kch * 8, vlane = (4 * pva + (lane >> 4)) * 128 + vch * 8;
    const unsigned kdst = lds0 + wid * 1024, vdstA = lds0 + 16384 + pva * 1024, vdstB = lds0 + 16384 + pvb * 1024;
#define DMA_TILE(t, sl) do { const size_t ko_ = (size_t)(t) * 64 * 64, vo_ = (size_t)(t) * 64 * 128; const unsigned so_ = (unsigned)(sl) * ASLOT; \
        GLDS(ksrc0 + ko_, kdst + so_); GLDS(ksrc0 + (size_t)SEQ * 64 + ko_, kdst + 8192 + so_); GLDS(vsrcA + vo_, vdstA + so_); GLDS(vsrcB + vo_, vdstB + so_); } while (0)
    asm volatile("" ::: "memory");
    if (!pre) { DMA_TILE(t_lo, s0);
        if (NT > 1) DMA_TILE(t_lo + 1, s0 + 1); }
    if (NT > 2) DMA_TILE(t_lo + 2, (s0 + 2) & 3);
    f32x16 bias0;
#pragma unroll
    for (int r = 0; r < 16; ++r) bias0[r] = slope2 * (float)(crow(r, hi) - qloc);
    const float s32 = 32.f * slope2;
    float l = 0.f;
    f32x16 o[4];
#pragma unroll
    for (int db = 0; db < 4; ++db)
#pragma unroll
        for (int r = 0; r < 16; ++r) o[db][r] = 0.f;
    const int kofs = j * 8192 + r32 * 128;
    const int kx0 = (hi ^ ((r32 >> 1) & 7)) * 16;
    const int vx0 = 256 * (4 * hi + ((lane & 15) >> 2)) + 16 * (4 * ((lane >> 2) & 3) + 2 * ((lane >> 4) & 1) + ((lane >> 1) & 1)) + 8 * (lane & 1);
    const int qfirst = q0 + 32 * wq, qlast = qfirst + 31;
    const int NTw = (64 * (t_lo + NT - 1) <= qlast) ? NT : NT - 1;
    f32x16 p0, p1;
#define SB0() __builtin_amdgcn_sched_barrier(0)
#define PINV(x) asm volatile("" : "+v"(x))
#define KLD(kf, sl, d0) do { const lds_cptr kb_ = (lds_cptr)lds + (sl) * ASLOT + kofs + (kx0 ^ (32 * (d0))); kf[0] = *(const LAS bf16x8*)(kb_); kf[1] = *(const LAS bf16x8*)(kb_ + 4096); } while (0)
    struct VF1 { s16x4 lo, hh; };
#define VLD1(vf, sl, g_) do { const lds_cptr vb_ = (lds_cptr)lds + (sl) * ASLOT + 16384 + (vx0 ^ (64 * ((g_) >> 2))) + ((g_) & 3) * 4096; vf.lo = vtr(vb_); vf.hh = vtr(vb_ + 2048); } while (0)
#define VF8(vf) ((bf16x8){vf.lo[0], vf.lo[1], vf.lo[2], vf.lo[3], vf.hh[0], vf.hh[1], vf.hh[2], vf.hh[3]})
#define QK8(sl) do { bf16x8 ka[2], kb2[2], kc[2], kd[2]; \
        KLD(ka, sl, 0); KLD(kb2, sl, 1); KLD(kc, sl, 2); KLD(kd, sl, 3); SB0(); \
        p0 = MFMA32(ka[0], qf[0], bias0); p1 = MFMA32(ka[1], qf[0], bias0); p0 = MFMA32(kb2[0], qf[1], p0); p1 = MFMA32(kb2[1], qf[1], p1); \
        p0 = MFMA32(kc[0], qf[2], p0); p1 = MFMA32(kc[1], qf[2], p1); p0 = MFMA32(kd[0], qf[3], p0); p1 = MFMA32(kd[1], qf[3], p1); SB0(); } while (0)
#define KLOADS(sl) bf16x8 ka[2], kb2[2], kc[2], kd[2]; KLD(ka, sl, 0); KLD(kb2, sl, 1); KLD(kc, sl, 2); KLD(kd, sl, 3); SB0()
#define QKMMA() do { p0 = MFMA32(ka[0], qf[0], bias0); p1 = MFMA32(ka[1], qf[0], bias0); p0 = MFMA32(kb2[0], qf[1], p0); p1 = MFMA32(kb2[1], qf[1], p1); \
        p0 = MFMA32(kc[0], qf[2], p0); p1 = MFMA32(kc[1], qf[2], p1); p0 = MFMA32(kd[0], qf[3], p0); p1 = MFMA32(kd[1], qf[3], p1); SB0(); } while (0)
#define MASK(t) do { if (64 * (t) + 63 > qfirst) { const int qh = qpos - 64 * (t) - 4 * hi; \
            _Pragma("unroll") for (int r = 0; r < 16; ++r) { const int cr = (r & 3) + 8 * (r >> 2); if (cr > qh) p0[r] = -INFINITY; if (cr + 32 > qh) p1[r] = -INFINITY; } SB0(); } } while (0)
    u32x4 pc0, pc1, pc2, pc3;
    if (NT > 2) { WAIT_BAR(4); } else { WAIT_BAR(0); }
    int pend = 1 << 20; if (tid == 0) pend = (int)atomicAdd(qheads + 64 * b, 1u);
    QK8(s0); MASK(t_lo);
    { const float c0 = slope2 * (float)(64 * t_lo - q0) - smax2, c1 = c0 + s32; float rs = 0.f;
#pragma unroll
      for (int r = 0; r < 16; ++r) { p0[r] = __builtin_amdgcn_exp2f(p0[r] + c0); p1[r] = __builtin_amdgcn_exp2f(p1[r] + c1); rs += p0[r] + p1[r]; }
      l += rs;
      pc0 = (u32x4){cvtpk(p0[0], p0[1]), cvtpk(p0[2], p0[3]), cvtpk(p0[4], p0[5]), cvtpk(p0[6], p0[7])};
      pc1 = (u32x4){cvtpk(p0[8], p0[9]), cvtpk(p0[10], p0[11]), cvtpk(p0[12], p0[13]), cvtpk(p0[14], p0[15])};
      pc2 = (u32x4){cvtpk(p1[0], p1[1]), cvtpk(p1[2], p1[3]), cvtpk(p1[4], p1[5]), cvtpk(p1[6], p1[7])};
      pc3 = (u32x4){cvtpk(p1[8], p1[9]), cvtpk(p1[10], p1[11]), cvtpk(p1[12], p1[13]), cvtpk(p1[14], p1[15])}; SB0(); }
    for (int i = 0; i + 1 < NTw; ++i) {
        const int t = t_lo + i;
        if (i + 2 < NT) { WAIT_BAR(4); } else { WAIT_BAR(0); }
        {
            const int sv = (i + s0) & 3;
            KLOADS((i + 1 + s0) & 3);
            VF1 vcur, vn1; VLD1(vcur, sv, 0); VLD1(vn1, sv, 1); SB0();
            if (i + 3 < NT) DMA_TILE(t + 3, (i + 3 + s0) & 3);
            const bf16x8 q0_ = __builtin_bit_cast(bf16x8, pc0), q1_ = __builtin_bit_cast(bf16x8, pc1), q2_ = __builtin_bit_cast(bf16x8, pc2), q3_ = __builtin_bit_cast(bf16x8, pc3);
            SB0();
            QKMMA(); MASK(t + 1);
            const float c0 = slope2 * (float)(64 * (t + 1) - q0) - smax2, c1 = c0 + s32; float rs = 0.f;
            u32x4 n0, n1, n2, n3;
#pragma unroll
            for (int g = 0; g < 16; ++g) {
                VF1 vn2; if (g < 14) VLD1(vn2, sv, g + 2);
                const bf16x8 pk_ = (g & 3) == 0 ? q0_ : (g & 3) == 1 ? q1_ : (g & 3) == 2 ? q2_ : q3_;
                o[g >> 2] = MFMA32(VF8(vcur), pk_, o[g >> 2]);
                p0[g] = __builtin_amdgcn_exp2f(p0[g] + c0); p1[g] = __builtin_amdgcn_exp2f(p1[g] + c1); rs += p0[g] + p1[g];
                PINV(p0[g]); PINV(p1[g]); PINV(rs);
                if (g & 1) { const unsigned wa = cvtpk(p0[g - 1], p0[g]), wb = cvtpk(p1[g - 1], p1[g]); const int k = g >> 1;
                    if (k < 4) { n0[k & 3] = wa; n2[k & 3] = wb; } else { n1[k & 3] = wa; n3[k & 3] = wb; } }
                SB0();
                vcur = vn1; if (g < 14) vn1 = vn2;
            }
            l += rs;
            pc0 = n0; pc1 = n1; pc2 = n2; pc3 = n3;
        }
    }
    {
        const int i = NTw - 1;
        if (i + 2 < NT) { WAIT_BAR(4); } else { WAIT_BAR(0); }
        if (i + 3 < NT) DMA_TILE(t_lo + i + 3, (i + 3 + s0) & 3);
        const int sv = (i + s0) & 3;
        const bf16x8 q0_ = __builtin_bit_cast(bf16x8, pc0), q1_ = __builtin_bit_cast(bf16x8, pc1), q2_ = __builtin_bit_cast(bf16x8, pc2), q3_ = __builtin_bit_cast(bf16x8, pc3);
        VF1 vcur; VLD1(vcur, sv, 0);
#pragma unroll
        for (int g = 0; g < 16; ++g) {
            VF1 vnx; if (g < 15) VLD1(vnx, sv, g + 1);
            const bf16x8 pk_ = (g & 3) == 0 ? q0_ : (g & 3) == 1 ? q1_ : (g & 3) == 2 ? q2_ : q3_;
            o[g >> 2] = MFMA32(VF8(vcur), pk_, o[g >> 2]);
            SB0();
            if (g < 15) vcur = vnx;
        }
    }
    if (NTw < NT) { WAIT_BAR(0); }
#undef KLD
#undef VLD1
#undef VF8
#undef QK8
#undef KLOADS
#undef QKMMA
#undef MASK
#undef PINV
#undef DMA_TILE
    l = half_swap_sum(l);
    const float rl = 1.0f / l;
    if (my_tid(wave_) == 0) {
        int d_ = -1;
        if (pend < 512) d_ = (b << 16) | utab[pend];
        else for (int qi_ = ((b - xcc) & 7) + 1; qi_ < 8; ++qi_) { const int bq_ = (xcc + qi_) & 7; const int ix_ = (int)atomicAdd(qheads + 64 * bq_, 1u); if (ix_ < 512) { d_ = (bq_ << 16) | utab[ix_]; break; } }
        *nextw = d_;
    }
    WAIT_BAR(0);
    const int lane2 = my_tid(wave_) & 63, hi2 = lane2 >> 5;
    {
        const int nd = *nextw;
        if (nd >= 0) {
            const int nb = nd >> 16, nh = (nd >> 6) & 7, nqb = nd & 63, ndd = nqb * 128 - cuts[nh], ntl = ndd > 0 ? ndd >> 6 : 0, nNT = 2 * nqb + 2 - ntl;
            const bf16_t* nk = KA + (size_t)(nb * 16 + 2 * nh) * SEQ * 64 + klane + (size_t)ntl * 64 * 64;
            const bf16_t* nv = VA + (size_t)(nb * 8 + nh) * SEQ * 128 + vlane + (size_t)ntl * 64 * 128;
            const unsigned so_ = (unsigned)(s0 ^ 2) * ASLOT;
            GLDS(nk, kdst + so_); GLDS(nk + (size_t)SEQ * 64, kdst + 8192 + so_); GLDS(nv, vdstA + so_); GLDS(nv + 4 * 128, vdstB + so_);
            if (nNT > 1) { GLDS(nk + 64 * 64, kdst + so_ + ASLOT); GLDS(nk + (size_t)SEQ * 64 + 64 * 64, kdst + 8192 + so_ + ASLOT); GLDS(nv + 64 * 128, vdstA + so_ + ASLOT); GLDS(nv + 64 * 128 + 4 * 128, vdstB + so_ + ASLOT); }
            const bf16_t* Qn = QA + ((size_t)nb * SEQ + nqb * 128 + 32 * wq + (lane2 & 31)) * 1024 + (2 * nh + j) * 64 + hi2 * 8;
#pragma unroll
            for (int d0 = 0; d0 < 4; ++d0) qio[d0] = *(const bf16x8*)(Qn + d0 * 16);
        }
    }
    LAS float* xch = (LAS float*)(lds + s0 * ASLOT) + wq * 4096 + lane2;
    if (j == 1) {
#pragma unroll
        for (int db = 0; db < 4; ++db)
#pragma unroll
            for (int r = 0; r < 16; ++r) xch[(db * 16 + r) * 64] = o[db][r] * rl;
    }
    WAIT_BAR(0);
    if (j == 0) {
        float ss = 0.f;
#pragma unroll
        for (int db = 0; db < 4; ++db) {
            SB0();
#pragma unroll
            for (int r = 0; r < 16; ++r) { const float v = o[db][r] * rl - lam * xch[(db * 16 + r) * 64]; o[db][r] = v; ss += v * v; }
        }
        ss = half_swap_sum(ss);
        const float rstd = rsqrtf(ss * (1.0f / 128.0f) + 1e-6f) * 0.8f;
        const size_t rowoff = ((size_t)b * SEQ + q0 + 32 * wq + (lane2 & 31)) * 1024 + h * 128;
#pragma unroll
        for (int db = 0; db < 4; ++db) {
            SB0();
#pragma unroll
            for (int rg = 0; rg < 4; ++rg) {
                const int d = 32 * db + 8 * rg + 4 * hi2;
                const f32x4 g = *(const f32x4*)(subg + d);
                const u32x2 zz = *(const u32x2*)(ZA + rowoff + d);
                const float v0 = o[db][4 * rg + 0] * rstd * g[0] * bf_lo(zz.x), v1 = o[db][4 * rg + 1] * rstd * g[1] * bf_hi(zz.x);
                const float v2 = o[db][4 * rg + 2] * rstd * g[2] * bf_lo(zz.y), v3 = o[db][4 * rg + 3] * rstd * g[3] * bf_hi(zz.y);
                u32x2 w; w.x = cvtpk(v0, v1); w.y = cvtpk(v2, v3);
                *(u32x2*)(OA + rowoff + d) = w;
            }
        }
    }
    WAIT_BAR(0);
}

__device__ __forceinline__ void attnB_stage(const int wave_, const int lane, unsigned bufaddr, int b, int kvh, int nb, const bf16_t* KVS) {
    const int krow = 8 * wave_ + (lane >> 3), kch = (lane & 7) ^ ((krow >> 1) & 7), vch = (lane & 7) ^ (((krow >> 1) & 1) << 2);
    const long row0 = (long)b * SEQ + 128L * (nb - 1) + krow;
    const bf16_t* ksrc = KVS + row0 * 256 + kvh * 64 + kch * 8;
    const bf16_t* vsrc = KVS + row0 * 256 + 128 + kvh * 64 + vch * 8;
    for (int bt = (nb == 0 ? 2 : 0); bt < 4; ++bt) { GLDS(ksrc + (size_t)bt * 64 * 256, bufaddr + bt * 16384 + wave_ * 1024); GLDS(vsrc + (size_t)bt * 64 * 256, bufaddr + bt * 16384 + 8192 + wave_ * 1024); }
}
__device__ __forceinline__ void attnB_unit(const int wave_, LAS unsigned char* buf, int b, int kvh, int nb, float smax2,
                                           const bf16_t* QB, const bf16_t* ZB, bf16_t* OB, const float* sinks) {
    const int tid = my_tid(wave_);
    const int lane = tid & 63, r32 = lane & 31, hi = lane >> 5;
    const int hq = kvh * 8 + wave_;
    const size_t rowbase = (size_t)b * SEQ;
    const float slope2 = exp2f(-0.5f * (float)(hq + 1)) * LOG2E, sink2 = sinks[hq] * LOG2E;
    const float ref = fmaxf(smax2, sink2), psink = __builtin_amdgcn_exp2f(sink2 - ref);
    const int bt0 = nb == 0 ? 2 : 0;
    const int kx0 = r32 * 128 + (hi ^ ((r32 >> 1) & 7)) * 16;
    const int rq = (lane & 15) >> 2;
    const int vx0 = 8192 + 128 * (4 * hi + rq) + 64 * (rq >> 1) + 32 * ((lane >> 4) & 1) + 8 * (lane & 3);
    const int qh = r32 - 4 * hi;
    f32x16 biasB;
#pragma unroll
    for (int r = 0; r < 16; ++r) biasB[r] = slope2 * (float)((r & 3) + 8 * (r >> 2));
    bf16x8 qf[4], qn[4];
    { const bf16_t* Qp = QB + (rowbase + nb * 128 + r32) * 1024 + hq * 64 + hi * 8;
#pragma unroll
      for (int d0 = 0; d0 < 4; ++d0) qf[d0] = *(const bf16x8*)(Qp + d0 * 16); }
    for (int rb = 0; rb < 4; ++rb) {
        const size_t rowoff = (rowbase + nb * 128 + 32 * rb + r32) * 1024 + hq * 64;
        if (rb < 3) {
#pragma unroll
            for (int d0 = 0; d0 < 4; ++d0) qn[d0] = *(const bf16x8*)(QB + rowoff + 32 * 1024 + d0 * 16 + hi * 8);
        }
        u32x2 zz[2][4];
#pragma unroll
        for (int db = 0; db < 2; ++db)
#pragma unroll
            for (int rg = 0; rg < 4; ++rg) zz[db][rg] = *(const u32x2*)(ZB + rowoff + 32 * db + 8 * rg + 4 * hi);
        float l = hi == 0 ? psink : 0.0f;
        f32x16 o[2];
#pragma unroll
        for (int db = 0; db < 2; ++db)
#pragma unroll
            for (int r = 0; r < 16; ++r) o[db][r] = 0.f;
        for (int tt = 0; tt < 3; ++tt) {
            const int bt = (rb >> 1) + tt;
            if (bt < bt0) continue;
            const lds_cptr tb = (lds_cptr)buf + bt * 16384;
            f32x16 p0, p1;
            { bf16x8 ka[2], kb2[2], kc[2], kd[2];
              ka[0] = *(const LAS bf16x8*)(tb + kx0); ka[1] = *(const LAS bf16x8*)(tb + kx0 + 4096);
              kb2[0] = *(const LAS bf16x8*)(tb + (kx0 ^ 32)); kb2[1] = *(const LAS bf16x8*)(tb + (kx0 ^ 32) + 4096);
              kc[0] = *(const LAS bf16x8*)(tb + (kx0 ^ 64)); kc[1] = *(const LAS bf16x8*)(tb + (kx0 ^ 64) + 4096);
              kd[0] = *(const LAS bf16x8*)(tb + (kx0 ^ 96)); kd[1] = *(const LAS bf16x8*)(tb + (kx0 ^ 96) + 4096);
              __builtin_amdgcn_sched_barrier(0);
              p0 = MFMA32(ka[0], qf[0], biasB); p1 = MFMA32(ka[1], qf[0], biasB); p0 = MFMA32(kb2[0], qf[1], p0); p1 = MFMA32(kb2[1], qf[1], p1);
              p0 = MFMA32(kc[0], qf[2], p0); p1 = MFMA32(kc[1], qf[2], p1); p0 = MFMA32(kd[0], qf[3], p0); p1 = MFMA32(kd[1], qf[3], p1);
              __builtin_amdgcn_sched_barrier(0); }
            s16x4 lo_, hh_, lo1_, hh1_;
            lo_ = vtr(tb + vx0); hh_ = vtr(tb + vx0 + 1024); lo1_ = vtr(tb + vx0 + 2048); hh1_ = vtr(tb + vx0 + 2048 + 1024);
            __builtin_amdgcn_sched_barrier(0);
            const int D0 = 128 + 32 * rb - 64 * bt;
            const float c0 = -slope2 * (float)(D0 + qh) - ref, c1 = c0 + 32.f * slope2;
            float rs = 0.f;
#pragma unroll
            for (int r = 0; r < 16; ++r) { p0[r] = __builtin_amdgcn_exp2f(p0[r] + c0); p1[r] = __builtin_amdgcn_exp2f(p1[r] + c1); }
#define MASKH(P, Dn) do { if ((Dn) == 128) { _Pragma("unroll") for (int r = 0; r < 16; ++r) { const int cr = (r & 3) + 8 * (r >> 2); if (!(cr > qh)) P[r] = 0.f; } } \
                else if ((Dn) == 0) { _Pragma("unroll") for (int r = 0; r < 16; ++r) { const int cr = (r & 3) + 8 * (r >> 2); if (cr > qh) P[r] = 0.f; } } \
                else if ((Dn) < 0 || (Dn) > 128) { _Pragma("unroll") for (int r = 0; r < 16; ++r) P[r] = 0.f; } } while (0)
            MASKH(p0, D0); MASKH(p1, D0 - 32);
#undef MASKH
#pragma unroll
            for (int r = 0; r < 16; ++r) rs += p0[r] + p1[r];
            l += rs;
            bf16x8 pf[4]; pack_p(pf, p0, p1);
            __builtin_amdgcn_sched_barrier(0);
            {
                s16x4 lo2_, hh2_;
#pragma unroll
                for (int g = 0; g < 8; ++g) {
                    if (g < 6) { const int g2 = g + 2; lo2_ = vtr(tb + (vx0 ^ (64 * (g2 >> 2))) + (g2 & 3) * 2048); hh2_ = vtr(tb + (vx0 ^ (64 * (g2 >> 2))) + (g2 & 3) * 2048 + 1024); }
                    const bf16x8 vf = (bf16x8){lo_[0], lo_[1], lo_[2], lo_[3], hh_[0], hh_[1], hh_[2], hh_[3]};
                    o[g >> 2] = MFMA32(vf, pf[g & 3], o[g >> 2]);
                    __builtin_amdgcn_sched_barrier(0);
                    lo_ = lo1_; hh_ = hh1_; if (g < 6) { lo1_ = lo2_; hh1_ = hh2_; }
                }
            }
        }
        l = half_swap_sum(l);
        const float rl = 1.0f / l;
#pragma unroll
        for (int db = 0; db < 2; ++db)
#pragma unroll
            for (int rg = 0; rg < 4; ++rg) {
                const int d = 32 * db + 8 * rg + 4 * hi;
                const u32x2 z_ = zz[db][rg];
                const float v0 = o[db][4 * rg + 0] * rl * bf_lo(z_.x), v1 = o[db][4 * rg + 1] * rl * bf_hi(z_.x);
                const float v2 = o[db][4 * rg + 2] * rl * bf_lo(z_.y), v3 = o[db][4 * rg + 3] * rl * bf_hi(z_.y);
                u32x2 w; w.x = cvtpk(v0, v1); w.y = cvtpk(v2, v3);
                *(u32x2*)(OB + rowoff + d) = w;
            }
        if (rb < 3) {
#pragma unroll
            for (int d0 = 0; d0 < 4; ++d0) qf[d0] = qn[d0];
        }
    }
}

__device__ __forceinline__ int permrow(int a) { const int r = a & 255; return (a & ~255) + ((r >> 5) & 1) * 128 + (r >> 6) * 32 + (r & 31); }
__device__ __forceinline__ void p0_transpose_item(const float* W, int K, int N, bf16_t* WT, LAS float* scr, int item, int lane, const float* kgain = nullptr, const float* kscale = nullptr) {
    const int nblk = N / 32, kb = item / nblk, nb = item - kb * nblk, k0 = 64 * kb, n0 = 32 * nb;
#pragma unroll 8
    for (int i = 0; i < 32; ++i) { const int kk = 2 * i + (lane >> 5); scr[kk * 33 + (lane & 31)] = W[(size_t)(k0 + kk) * N + n0 + (lane & 31)]; }
    LDS_WAIT();
    const int c = lane & 7;
    const int prow0 = permrow(n0);
#pragma unroll
    for (int jj = 0; jj < 4; ++jj) { const int n = (lane >> 3) + 8 * jj; const LAS float* s = scr + (8 * c) * 33 + n;
        f32x4 m0 = {1.f, 1.f, 1.f, 1.f}, m1 = {1.f, 1.f, 1.f, 1.f};
        if (kgain) { m0 = *(const f32x4*)(kgain + k0 + 8 * c) * (*(const f32x4*)(kscale + k0 + 8 * c) + 1.0f); m1 = *(const f32x4*)(kgain + k0 + 8 * c + 4) * (*(const f32x4*)(kscale + k0 + 8 * c + 4) + 1.0f); }
        u32x4 o; o.x = cvtpk(s[0 * 33] * m0[0], s[1 * 33] * m0[1]); o.y = cvtpk(s[2 * 33] * m0[2], s[3 * 33] * m0[3]); o.z = cvtpk(s[4 * 33] * m1[0], s[5 * 33] * m1[1]); o.w = cvtpk(s[6 * 33] * m1[2], s[7 * 33] * m1[3]);
        *(u32x4*)(WT + (size_t)(prow0 + n) * K + k0 + 8 * c) = o; }
    LDS_WAIT();
}
template <bool TWO, bool IN_BF16> __device__ __forceinline__ void norm_chunk(const void* Xv, int chunk, int lane,
        const float* g1, const float* sh1, const float* sc1, bf16_t* out1, const float* g2, const float* sh2, const float* sc2, bf16_t* out2, float* rstd_out = nullptr) {
    f32x4 A1[4], S1[4], A2[4], S2[4];
#pragma unroll
    for (int jj = 0; jj < 4; ++jj) { const int col = 4 * lane + 256 * jj;
        A1[jj] = *(const f32x4*)(g1 + col) * (*(const f32x4*)(sc1 + col) + 1.0f); S1[jj] = *(const f32x4*)(sh1 + col);
        if (TWO) { A2[jj] = *(const f32x4*)(g2 + col) * (*(const f32x4*)(sc2 + col) + 1.0f); S2[jj] = *(const f32x4*)(sh2 + col); } }
    for (int rr = 0; rr < 32; ++rr) {
        const size_t row = (size_t)chunk * 32 + rr;
        f32x4 v[4]; float ss = 0.f;
#pragma unroll
        for (int jj = 0; jj < 4; ++jj) {
            if (IN_BF16) { const u32x2 w = *(const u32x2*)((const bf16_t*)Xv + row * 1024 + 4 * lane + 256 * jj); v[jj] = (f32x4){bf_lo(w.x), bf_hi(w.x), bf_lo(w.y), bf_hi(w.y)}; }
            else v[jj] = *(const f32x4*)((const float*)Xv + row * 1024 + 4 * lane + 256 * jj);
            ss += (v[jj][0] * v[jj][0] + v[jj][1] * v[jj][1]) + (v[jj][2] * v[jj][2] + v[jj][3] * v[jj][3]); }
        const float rstd = rsqrtf(wave_sum(ss) * (1.0f / 1024.0f) + 1e-6f);
        if (rstd_out && lane == 0) rstd_out[row] = rstd;
#pragma unroll
        for (int jj = 0; jj < 4; ++jj) {
            const f32x4 xn = v[jj] * rstd;
            if (out1) { const f32x4 u = xn * A1[jj] + S1[jj]; u32x2 w; w.x = cvtpk(u[0], u[1]); w.y = cvtpk(u[2], u[3]); *(u32x2*)(out1 + row * 1024 + 4 * lane + 256 * jj) = w; }
            if (TWO) { const f32x4 u = xn * A2[jj] + S2[jj]; u32x2 w; w.x = cvtpk(u[0], u[1]); w.y = cvtpk(u[2], u[3]); *(u32x2*)(out2 + row * 1024 + 4 * lane + 256 * jj) = w; }
        }
    }
}

struct RowOrder {
    int nM, nN, G, c;
    __device__ void init(int M, int N, int G_, int c_) { nM = M / 256; nN = N / 256; G = G_; c = c_; }
    __device__ bool next(int i, pg8::Unit& u) const { const int pm = c + (i / nN) * G; if (pm >= nM) return false; u.pm = pm; u.pn = i % nN; return true; }
    __device__ __forceinline__ void a_ready(const pg8::Unit&) const {}
    __device__ __forceinline__ void done(const pg8::Unit&) const {}
};
struct Params { const float* in[26]; float* out; unsigned char* ws; int ph_lo, ph_hi; };

__global__ void __launch_bounds__(NTHREADS) yoco_fwd(Params P) {
    extern __shared__ __attribute__((aligned(16))) unsigned char lds_raw[];
    LAS unsigned char* lds = (LAS unsigned char*)lds_raw;
    const unsigned lds0 = (unsigned)(uintptr_t)lds_raw;
    LAS unsigned char* ring = lds + 16384; const unsigned ring0 = lds0 + 16384u;
    cg::grid_group grid = cg::this_grid();
    const int wave = __builtin_amdgcn_readfirstlane(threadIdx.x >> 6);
    const int G = gridDim.x, bx = blockIdx.x;
    const int vcu = (G % 8 == 0) ? (bx % 8) * (G / 8) + bx / 8 : bx;
    const int gw = vcu * 8 + wave, NGW = G * 8;
    unsigned char* ws = P.ws;
    const float* x = P.in[0];
    float* modA = (float*)(ws + WS_MOD); float* modKV = modA + 8 * 3072; float* modB = modKV + 8 * 2048;
    float* ctlf = (float*)(ws + WS_CTL);
    bf16_t* WinA = (bf16_t*)(ws + WS_WINA); bf16_t* WoutA = (bf16_t*)(ws + WS_WOUTA); bf16_t* Wkv = (bf16_t*)(ws + WS_WKV); bf16_t* WinB = (bf16_t*)(ws + WS_WINB); bf16_t* WoutB = (bf16_t*)(ws + WS_WOUTB);
    bf16_t* R0 = (bf16_t*)(ws + WS_R0); bf16_t* R1 = (bf16_t*)(ws + WS_R1); bf16_t* R2 = (bf16_t*)(ws + WS_R2); bf16_t* R3 = (bf16_t*)(ws + WS_R3); bf16_t* R4 = (bf16_t*)(ws + WS_R4);
    float* H = (float*)(ws + WS_H);
    const int lo = P.ph_lo, hi_ = P.ph_hi;
#ifndef REP_MASK
#define REP_MASK 0
#endif
#define NREP(k) ((((REP_MASK) >> (k)) & 1) + 1)
#ifndef PH_MASK
#define PH_MASK 0x1ff
#endif
#define IN(k) (((PH_MASK >> (k)) & 1) && lo <= (k) && (k) < hi_)
    unsigned* const xbar = (unsigned*)ctlf + 4096;
    const unsigned xcc_id = (unsigned)__builtin_amdgcn_s_getreg((3 << 11) | 20) & 0xFu;
    volatile LAS unsigned* const xst = (volatile LAS unsigned*)(lds + 8192);
#define GBAR() grid_bar(xbar, xcc_id, xst, wave)
#define SEAM(k) do { if (IN(k) && IN((k) + 1)) { if ((k) == 0) { grid.sync(); if (my_tid(wave) == 0) { xst[0] = 0u; xst[1] = 0u; (void)xb_add(&xbar[XB_XCNT(xcc_id)], 1u); } } else GBAR(); } } while (0)

    if (IN(0)) {
        const int tid = my_tid(wave), lane = tid & 63;
        LAS float* sc = (LAS float*)lds;
        LAS float* red = (LAS float*)(lds + 32768);
        const float* c = P.in[1];
        for (int i = tid; i < 8192; i += NTHREADS) { const int bb = i >> 10, k = i & 1023; const float v = c[i]; sc[k * 8 + bb] = v / (1.0f + __expf(-v)); }
        __syncthreads();
        for (int cgp = bx; cgp < 256; cgp += G) {
            const int n0 = cgp * 32;
            const float* W; const float* bias; int N, nloc; float* dst;
            if (n0 < 3072) { W = P.in[3]; bias = P.in[4]; N = 3072; nloc = n0; dst = modA; }
            else if (n0 < 5120) { W = P.in[15]; bias = P.in[16]; N = 2048; nloc = n0 - 3072; dst = modKV; }
            else { W = P.in[20]; bias = P.in[21]; N = 3072; nloc = n0 - 5120; dst = modB; }
            const int col = tid & 31, ks = tid >> 5;
            f32x4 a0 = {0.f, 0.f, 0.f, 0.f}, a1 = {0.f, 0.f, 0.f, 0.f};
#pragma unroll 8
            for (int kk = 0; kk < 64; ++kk) { const int k = ks * 64 + kk; const float w = W[(size_t)k * N + nloc + col];
                const f32x4 s0 = *(const LAS f32x4*)(sc + k * 8), s1 = *(const LAS f32x4*)(sc + k * 8 + 4); a0 += s0 * w; a1 += s1 * w; }
#pragma unroll
            for (int e = 0; e < 4; ++e) { red[(ks * 8 + e) * 32 + col] = a0[e]; red[(ks * 8 + 4 + e) * 32 + col] = a1[e]; }
            __syncthreads();
            if (tid < 256) { const int bb = tid >> 5, cc = tid & 31; float s = bias[nloc + cc];
#pragma unroll
                for (int k2 = 0; k2 < 16; ++k2) s += red[(k2 * 8 + bb) * 32 + cc];
                dst[(size_t)bb * N + nloc + cc] = s; }
            __syncthreads();
        }
        if (bx == 0 && wave == 0) {
            float a = P.in[8][lane] * P.in[9][lane], bq = P.in[10][lane] * P.in[11][lane];
            a = wave_sum(a); bq = wave_sum(bq);
            if (lane == 0) ctlf[0] = __expf(a) - __expf(bq) + 0.2f;
            const float gq = P.in[6][lane], gk = P.in[7][lane];
            ctlf[64 + lane] = gq; ctlf[128 + lane] = gk;
            float mq = fabsf(gq), mk = fabsf(gk);
#pragma unroll
            for (int o_ = 1; o_ < 64; o_ <<= 1) { mq = fmaxf(mq, __shfl_xor(mq, o_)); mk = fmaxf(mk, __shfl_xor(mk, o_)); }
            const float smax2 = pg8::QK_C2 * 64.0f * mq * mk * 1.02f;
            if (lane == 0) ctlf[1] = smax2;
            { float mqb = fabsf(P.in[23][lane]), mkb = fabsf(P.in[18][lane]);
#pragma unroll
              for (int o_ = 1; o_ < 64; o_ <<= 1) { mqb = fmaxf(mqb, __shfl_xor(mqb, o_)); mkb = fmaxf(mkb, __shfl_xor(mkb, o_)); }
              if (lane == 0) ctlf[2] = pg8::QK_C2 * 64.0f * mqb * mkb * 1.02f; }
            if (lane < 8) { const float sl2 = exp2f(-(float)(lane + 1)) * LOG2E; const float cf = (2.0f * smax2 + 160.0f) / sl2;
                const int ci = cf > 1.0e6f ? 1000000 : (int)cf + 1; ((int*)ctlf)[16 + lane] = ci; ((LAS int*)(lds + 131072))[lane] = ci;
                ((unsigned*)ctlf)[256 + 64 * lane] = 0u; ((unsigned*)ctlf)[256 + 512 + 64 * lane] = 0u; }
        }
        __syncthreads();
        if (bx == 0) { for (int i_ = tid; i_ < XCD_BAR_WORDS; i_ += NTHREADS) ((unsigned*)ctlf)[4096 + i_] = 0u; }
        if (bx == 0) {
            LAS int* cuts = (LAS int*)(lds + 131072); LAS int* wk = cuts + 64;
            { const int hh = tid >> 6, qq = tid & 63, dd = qq * 128 - cuts[hh]; wk[tid] = 2 * qq + 2 - (dd > 0 ? dd >> 6 : 0); }
            __syncthreads();
            { const int mine = wk[tid]; int rank = 0;
              for (int k2 = 0; k2 < 512; ++k2) { const int wo = wk[k2]; rank += (wo > mine || (wo == mine && k2 < tid)) ? 1 : 0; }
              ((int*)ctlf)[2048 + rank] = tid; }
        }
        __syncthreads();
        LAS float* scr = (LAS float*)(lds + wave * 16384);
        constexpr int I_A = 16 * 128, I_OA = 16 * 32, I_KV = 16 * 8, I_B = 16 * 64, I_OB = 16 * 32;
        for (int it = gw; it < I_A + I_OA + I_KV + I_B + I_OB; it += NGW) {
            int r = it;
            if (r < I_A) { p0_transpose_item(P.in[5], 1024, 4096, WinA, scr, r, lane); continue; } r -= I_A;
            if (r < I_OA) { p0_transpose_item(P.in[13], 1024, 1024, WoutA, scr, r, lane); continue; } r -= I_OA;
            if (r < I_KV) { p0_transpose_item(P.in[17], 1024, 256, Wkv, scr, r, lane); continue; } r -= I_KV;
            if (r < I_B) { p0_transpose_item(P.in[22], 1024, 2048, WinB, scr, r, lane); continue; } r -= I_B;
            p0_transpose_item(P.in[25], 1024, 1024, WoutB, scr, r, lane);
        }
    }
    SEAM(0);
    bf16_t* const WkvB = (bf16_t*)(ws + 20 * MiB);
    float* const rstdH = (float*)(ws + 24 * MiB);
    float* const ckv = ctlf + 8192;
    if (IN(1)) for (int rep = 0; rep < NREP(1); ++rep) {
        if (rep) GBAR();
        const int lane = my_tid(wave) & 63;
        {
            LAS float* scr2 = (LAS float*)(ring + wave * 16384);
            for (int it = gw; it < 8 * 128; it += NGW) { const int bb = it >> 7;
                p0_transpose_item(P.in[17], 1024, 256, WkvB + (size_t)bb * 256 * 1024, scr2, it & 127, lane, P.in[14], modKV + bb * 2048 + 1024); }
            for (int d_ = gw; d_ < 2048; d_ += NGW) { const int bb = d_ >> 8, a_ = d_ & 255;
                const bf16_t* wr_ = Wkv + (size_t)permrow(a_) * 1024 + 16 * lane; const float* sh_ = modKV + bb * 2048 + 16 * lane;
                const u32x4 w0 = *(const u32x4*)wr_, w1 = *(const u32x4*)(wr_ + 8); float acc_ = 0.f;
                acc_ += bf_lo(w0.x) * sh_[0] + bf_hi(w0.x) * sh_[1] + bf_lo(w0.y) * sh_[2] + bf_hi(w0.y) * sh_[3] + bf_lo(w0.z) * sh_[4] + bf_hi(w0.z) * sh_[5] + bf_lo(w0.w) * sh_[6] + bf_hi(w0.w) * sh_[7];
                acc_ += bf_lo(w1.x) * sh_[8] + bf_hi(w1.x) * sh_[9] + bf_lo(w1.y) * sh_[10] + bf_hi(w1.y) * sh_[11] + bf_lo(w1.z) * sh_[12] + bf_hi(w1.z) * sh_[13] + bf_lo(w1.w) * sh_[14] + bf_hi(w1.w) * sh_[15];
                acc_ = wave_sum(acc_); if (lane == 0) ckv[d_] = acc_; }
        }
        for (int chunk = gw; chunk < MROWS / 32; chunk += NGW) {
            const int bb = chunk >> 8;
            norm_chunk<false, false>(x, chunk, lane, P.in[2], modA + bb * 3072, modA + bb * 3072 + 1024, R0, nullptr, nullptr, nullptr, nullptr);
        }
    }
    SEAM(1);
    if (IN(2)) for (int rep = 0; rep < NREP(2); ++rep) {
        if (rep) GBAR();
        pg8::Gemm g{R0, WinA, MROWS, 4096, 1024}; pg8::StaticOrder S; S.init(MROWS, 4096, G, bx);
        pg8::EpiProj E{R1, (size_t)(64 * MiB), ctlf + 64, 16, 1024, 0x03201102};
        pg8::gemm_phase<pg8::EpiProj, pg8::StaticOrder, true, true>(ring, g, S, E, wave);
    }
    SEAM(2);
    if (IN(3)) for (int rep = 0; rep < NREP(3); ++rep) {
        if (rep) GBAR();
        const float lam = ctlf[0], smax2 = ctlf[1];
        const int* ctli = (const int*)ctlf; unsigned* qheads = (unsigned*)ctlf + 256 + 512 * rep;
        LAS int* misc = (LAS int*)lds;
        const int xcc = (int)(__builtin_amdgcn_s_getreg((3 << 11) | 20) & 7u);
        { const int t0_ = my_tid(wave); if (t0_ < 8) misc[8 + t0_] = ctli[16 + t0_]; misc[64 + t0_] = ctli[2048 + t0_];
          if (t0_ == 0) { int d_ = -1; for (int qi_ = 0; qi_ < 8; ++qi_) { const int bq_ = (xcc + qi_) & 7; const int ix_ = (int)atomicAdd(qheads + 64 * bq_, 1u); if (ix_ < 512) { d_ = (bq_ << 16) | ctli[2048 + ix_]; break; } } misc[1] = d_; } }
        __syncthreads();
        int cur = misc[1], par = 0, s0 = 0, pre = 0;
        bf16x8 qio[4];
#pragma unroll
        for (int k = 0; k < 4; ++k) qio[k] = (bf16x8){0, 0, 0, 0, 0, 0, 0, 0};
        while (cur >= 0) {
            const int bq = cur >> 16, h = (cur >> 6) & 7, qb = cur & 63, dd = qb * 128 - misc[8 + h];
            attnA_unit(wave, ring, ring0, s0, pre, misc + 1 + (par ^ 1), misc + 8, misc + 64, qheads, xcc, qio, bq, h, qb, dd > 0 ? dd >> 6 : 0, smax2, R1, R2, R3, R4, R0, P.in[12], lam);
            cur = misc[1 + (par ^ 1)];
            par ^= 1; s0 ^= 2; pre = 1;
        }
    }
    SEAM(3);
    if (IN(4)) for (int rep = 0; rep < NREP(4); ++rep) {
        if (rep) GBAR();
        pg8::Gemm g{R0, WoutA, MROWS, 1024, 1024}; RowOrder S; S.init(MROWS, 1024, G, bx);
        pg8::EpiRes<false, true> E{x, (void*)H, modA + 2048, 3072};
        pg8::gemm_phase<pg8::EpiRes<false, true>, RowOrder, true, true>(ring, g, S, E, wave);
    }
    if (IN(5)) {
        asm volatile("s_waitcnt vmcnt(0)" ::: "memory"); __threadfence_block(); __syncthreads();
        bf16_t* UKVb = (bf16_t*)(ws + WS_H + 128 * MiB);
        const int lane = my_tid(wave) & 63;
        for (int pm = bx; pm < MROWS / 256; pm += G) {
            const int chunk = pm * 8 + wave, bb = chunk >> 8;
            norm_chunk<true, true>(H, chunk, lane, P.in[14], modKV + bb * 2048, modKV + bb * 2048 + 1024, nullptr, P.in[19], modB + bb * 3072, modB + bb * 3072 + 1024, R1, rstdH);
        }
    }
    SEAM(5);
    if (IN(6)) for (int rep = 0; rep < NREP(6); ++rep) {
        if (rep) GBAR();
        { pg8::Gemm g{(const bf16_t*)H, WkvB, MROWS, 256, 1024, (size_t)256 * 1024}; pg8::StaticOrder S; S.init(MROWS, 256, G, bx);
          pg8::EpiProj E{R4, (size_t)128, P.in[18], 2, 256, 0x00000001, rstdH, ckv, 256};
          pg8::gemm_phase<pg8::EpiProj, pg8::StaticOrder, true, true>(ring, g, S, E, wave); }
        { pg8::Gemm g{R1, WinB, MROWS, 2048, 1024}; pg8::StaticOrder S; S.init(MROWS, 2048, G, bx);
          pg8::EpiProj E{R2, (size_t)(64 * MiB), P.in[23], 16, 1024, 0x00000302};
          pg8::gemm_phase<pg8::EpiProj, pg8::StaticOrder, true, true>(ring, g, S, E, wave); }
    }
    SEAM(6);
    if (IN(7)) for (int rep = 0; rep < NREP(7); ++rep) {
        if (rep) GBAR();
        {
            const float smax2B = ctlf[2];
            const int lane_ = my_tid(wave) & 63;
            int u = vcu, par = 0;
            if (u < 1024) attnB_stage(wave, lane_, ring0, u >> 7, (u >> 6) & 1, u & 63, R4);
            for (; u < 1024; u += G, par ^= 1) {
                WAIT_BAR(0);
                if (u + G < 1024) { const int u2 = u + G; attnB_stage(wave, my_tid(wave) & 63, ring0 + (par ^ 1) * 65536u, u2 >> 7, (u2 >> 6) & 1, u2 & 63, R4); }
                attnB_unit(wave, ring + par * 65536, u >> 7, (u >> 6) & 1, u & 63, smax2B, R2, R3, R1, P.in[24]);
            }
            WAIT_BAR(0);
        }
    }
    SEAM(7);
    if (IN(8)) {
        pg8::Gemm g{R1, WoutB, MROWS, 1024, 1024}; pg8::StaticOrder S; S.init(MROWS, 1024, G, bx);
        pg8::EpiRes<true, false> E{H, P.out, modB + 2048, 3072};
        pg8::gemm_phase<pg8::EpiRes<true, false>, pg8::StaticOrder, true, true>(ring, g, S, E, wave);
    }
#undef IN
#undef SEAM
}

extern "C" void kernel_launch(void* const* d_in, const int* in_sizes, int n_in, void* d_out, int out_size, void* d_ws, size_t ws_size, hipStream_t stream) {
    static int grid = 0;
    if (grid == 0) {
        if (n_in != 26 || out_size != MROWS * DM || ws_size < WS_END) { fprintf(stderr, "kernel_launch: unexpected shapes (n_in %d out %d ws %zu)\n", n_in, out_size, ws_size); grid = -1; return; }
        int dev = 0, cus = 0, per_cu = 0;
        hipGetDevice(&dev); hipDeviceGetAttribute(&cus, hipDeviceAttributeMultiprocessorCount, dev);
        hipFuncSetAttribute((const void*)yoco_fwd, hipFuncAttributeMaxDynamicSharedMemorySize, LDS_BYTES);
        if (hipOccupancyMaxActiveBlocksPerMultiprocessor(&per_cu, (const void*)yoco_fwd, NTHREADS, LDS_BYTES) != hipSuccess || per_cu < 1) { fprintf(stderr, "kernel_launch: occupancy query gave %d\n", per_cu); per_cu = 1; }
        (void)hipGetLastError();
        grid = cus * per_cu;
    }
    if (grid < 0) return;
    Params p{};
    for (int i = 0; i < 26; ++i) p.in[i] = (const float*)d_in[i];
    p.out = (float*)d_out; p.ws = (unsigned char*)d_ws; p.ph_lo = 0; p.ph_hi = 9;
    void* args[] = {&p};
    hipError_t e = hipLaunchCooperativeKernel((const void*)yoco_fwd, dim3(grid), dim3(NTHREADS), args, LDS_BYTES, stream);
    if (e != hipSuccess) fprintf(stderr, "cooperative launch failed: %s (grid %d)\n", hipGetErrorString(e), grid);
}
```

```cpp
#include <hip/hip_runtime.h>
#include <hip/hip_cooperative_groups.h>
#include <cstdio>
#include <cstdint>
namespace cg = cooperative_groups;
namespace pg8 {
#define PG8_LAS __attribute__((address_space(3)))
typedef unsigned short bf16_t;
typedef short bf16x8 __attribute__((ext_vector_type(8)));
typedef float f32x4 __attribute__((ext_vector_type(4)));
typedef unsigned u32x4 __attribute__((ext_vector_type(4)));
constexpr int BM = 256, BK = 64, HALF = 128, HTB = HALF * BK * 2  , STAGE_BYTES = 8 * HTB, NXCD = 8, WGM = 8;

__host__ __device__ __forceinline__ int lds_byte(int r, int c) { const int st = (r >> 4) * 2 + (c >> 5), rr = r & 15, cc = c & 31, ob = rr * 64 + cc * 2; return st * 1024 + (ob ^ (((ob >> 9) & 1) << 5)); }
__host__ __device__ __forceinline__ void stage_rc(int b, int& R, int& C) { const int st = b / 1024, sb = b % 1024, swz = sb ^ (((sb >> 9) & 1) << 5); R = (st >> 1) * 16 + swz / 64; C = (st & 1) * 32 + (swz % 64) / 2; }
__host__ __device__ __forceinline__ int perm32(int rho) { const int n = rho >> 4, i = rho & 15; return 8 * (i >> 2) + 4 * n + (i & 3); }

struct Unit { int pm, pn; };
struct Gemm { const bf16_t* A; const bf16_t* Bt; int M, N, K; size_t bstride = 0; };

struct StaticOrder {
    int nM, nN, nwg, G, c;
    __host__ __device__ void init(int M, int N, int G_, int c_) { nM = M / BM; nN = N / BM; nwg = nM * nN; G = G_; c = c_; }
    __host__ __device__ bool next(int i, Unit& u) const {
        const long L = (long)i * G + c; if (L >= nwg) return false;
        int wgid = (int)L; { const int q = nwg / NXCD, r = nwg % NXCD, xcd = wgid % NXCD, off = wgid / NXCD; wgid = (xcd < r ? xcd * (q + 1) : r * (q + 1) + (xcd - r) * q) + off; }
        const int nig = WGM * nN, gid = wgid / nig, fm = gid * WGM, gsz = (nM - fm) < WGM ? (nM - fm) : WGM;
        u.pm = fm + ((wgid % nig) % gsz); u.pn = (wgid % nig) / gsz; return true;
    }
    __device__ __forceinline__ void a_ready(const Unit&) const {}
    __device__ __forceinline__ void done(const Unit&) const {}
};

__device__ __forceinline__ unsigned cvt_pk_bf16(float lo, float hi) { unsigned r; asm volatile("v_cvt_pk_bf16_f32 %0, %1, %2" : "=v"(r) : "v"(lo), "v"(hi)); return r; }
typedef unsigned u32x4e __attribute__((ext_vector_type(4)));
constexpr float QK_C2 = 0.125f * 1.4426950408889634f;
template <bool AFF> struct EpiProjT {
    static constexpr bool PERM = true, AFTER_DRAIN = false;
    bf16_t* out0; size_t tstride;
    const float* gtab;
    int hpt, ldo;
    int modes;
    const float* rstd = nullptr; const float* cbias = nullptr; int cb_ld = 0;
    __device__ __forceinline__ void operator()(const f32x4 (&acc)[2][2][4][2], const Unit& u, int wr, int wc, int fr, int fq) const {
        const int head = u.pn * 4 + wc, ty = head / hpt, hh = head - ty * hpt;
        bf16_t* base = out0 + (size_t)ty * tstride;
        const int mode = (modes >> (8 * ty)) & 15, lay = (modes >> (8 * ty + 4)) & 15;
        const float* g = gtab + 64 * ty;
        int row0 = u.pm * BM + wr * 64 + fr, colh = hh * 64 + 8 * fq, ldo = this->ldo;
        const int trow0 = row0;
        f32x4 cbv[2][2];
#pragma unroll
        for (int bj = 0; bj < 2; ++bj)
#pragma unroll
            for (int n = 0; n < 2; ++n) cbv[bj][n] = AFF ? *(const f32x4*)(cbias + (size_t)(u.pm >> 5) * cb_ld + head * 64 + 32 * bj + 8 * fq + 4 * n) : (f32x4){0.f, 0.f, 0.f, 0.f};
        if (lay == 1) { const int bb = row0 >> 13; row0 = (bb * hpt + hh) * 8192 + (row0 & 8191); colh = 8 * fq; ldo = 64; }
        else if (lay == 2) { const int bb = row0 >> 13; row0 = (bb * (hpt >> 1) + (hh >> 1)) * 8192 + (row0 & 8191); colh = (hh & 1) * 64 + 8 * fq; ldo = 128; }
        if (mode == 1 || mode == 2) {
            const float gs = mode == 2 ? QK_C2 : 1.0f;
            f32x4 gv[2][2];
#pragma unroll
            for (int bj = 0; bj < 2; ++bj)
#pragma unroll
                for (int n = 0; n < 2; ++n) gv[bj][n] = *(const f32x4*)(g + 32 * bj + 8 * fq + 4 * n) * gs;
#pragma unroll
            for (int ai = 0; ai < 2; ++ai)
#pragma unroll
                for (int m = 0; m < 4; ++m) {
                    const float rs_ = AFF ? rstd[trow0 + ai * HALF + m * 16] : 1.0f;
                    f32x4 xv[2][2];
                    float ss = 0.f;
#pragma unroll
                    for (int bj = 0; bj < 2; ++bj)
#pragma unroll
                        for (int n = 0; n < 2; ++n) { const f32x4 x = AFF ? acc[ai][bj][m][n] * rs_ + cbv[bj][n] : acc[ai][bj][m][n]; xv[bj][n] = x; ss += (x[0] * x[0] + x[1] * x[1]) + (x[2] * x[2] + x[3] * x[3]); }
                    { auto r16 = __builtin_amdgcn_permlane16_swap(__float_as_uint(ss), __float_as_uint(ss), false, false); ss = __uint_as_float(r16[0]) + __uint_as_float(r16[1]);
                      auto r32 = __builtin_amdgcn_permlane32_swap(__float_as_uint(ss), __float_as_uint(ss), false, false); ss = __uint_as_float(r32[0]) + __uint_as_float(r32[1]); }
                    const float rstd_h = rsqrtf(ss * (1.0f / 64.0f) + 1e-6f);
                    bf16_t* rowp = base + (size_t)(row0 + ai * HALF + m * 16) * ldo + colh;
#pragma unroll
                    for (int bj = 0; bj < 2; ++bj) { const f32x4 v0 = xv[bj][0] * rstd_h * gv[bj][0], v1 = xv[bj][1] * rstd_h * gv[bj][1];
                        u32x4e w; w.x = cvt_pk_bf16(v0[0], v0[1]); w.y = cvt_pk_bf16(v0[2], v0[3]); w.z = cvt_pk_bf16(v1[0], v1[1]); w.w = cvt_pk_bf16(v1[2], v1[3]);
                        *(u32x4e*)(rowp + bj * 32) = w; }
                }
        } else {
#pragma unroll
            for (int ai = 0; ai < 2; ++ai)
#pragma unroll
                for (int m = 0; m < 4; ++m) {
                    bf16_t* rowp = base + (size_t)(row0 + ai * HALF + m * 16) * ldo + colh;
                    const float rs_ = AFF ? rstd[trow0 + ai * HALF + m * 16] : 1.0f;
#pragma unroll
                    for (int bj = 0; bj < 2; ++bj) { f32x4 v0 = acc[ai][bj][m][0], v1 = acc[ai][bj][m][1]; if (AFF) { v0 = v0 * rs_ + cbv[bj][0]; v1 = v1 * rs_ + cbv[bj][1]; }
                        if (mode == 3) {
#pragma unroll
                            for (int e = 0; e < 4; ++e) { v0[e] = v0[e] * __builtin_amdgcn_rcpf(1.0f + __expf(-v0[e])); v1[e] = v1[e] * __builtin_amdgcn_rcpf(1.0f + __expf(-v1[e])); } }
                        u32x4e w; w.x = cvt_pk_bf16(v0[0], v0[1]); w.y = cvt_pk_bf16(v0[2], v0[3]); w.z = cvt_pk_bf16(v1[0], v1[1]); w.w = cvt_pk_bf16(v1[2], v1[3]);
                        *(u32x4e*)(rowp + bj * 32) = w; }
                }
        }
    }
};
typedef EpiProjT<false> EpiProj;
template <bool BASE_BF16, bool OUT_BF16> struct EpiRes {
    static constexpr bool PERM = true, AFTER_DRAIN = false;
    const void* base; void* out; const float* gate; int ldg;
    __device__ __forceinline__ void operator()(const f32x4 (&acc)[2][2][4][2], const Unit& u, int wr, int wc, int fr, int fq) const {
        const int col = (u.pn * 4 + wc) * 64 + 8 * fq, row0 = u.pm * BM + wr * 64 + fr;
        const float* gp = gate + (size_t)(u.pm >> 5) * ldg + col;
        f32x4 gv[2][2];
#pragma unroll
        for (int bj = 0; bj < 2; ++bj)
#pragma unroll
            for (int n = 0; n < 2; ++n) gv[bj][n] = *(const f32x4*)(gp + 32 * bj + 4 * n);
#pragma unroll
        for (int ai = 0; ai < 2; ++ai) {
            f32x4 bs[4][2][2];
#pragma unroll
            for (int m = 0; m < 4; ++m) { const size_t off = (size_t)(row0 + ai * HALF + m * 16) * 1024 + col;
#pragma unroll
                for (int bj = 0; bj < 2; ++bj) {
                    if (BASE_BF16) { const u32x4e w = *(const u32x4e*)((const bf16_t*)base + off + 32 * bj);
                        bs[m][bj][0] = (f32x4){__uint_as_float(w.x << 16), __uint_as_float(w.x & 0xffff0000u), __uint_as_float(w.y << 16), __uint_as_float(w.y & 0xffff0000u)};
                        bs[m][bj][1] = (f32x4){__uint_as_float(w.z << 16), __uint_as_float(w.z & 0xffff0000u), __uint_as_float(w.w << 16), __uint_as_float(w.w & 0xffff0000u)}; }
                    else { bs[m][bj][0] = *(const f32x4*)((const float*)base + off + 32 * bj); bs[m][bj][1] = *(const f32x4*)((const float*)base + off + 32 * bj + 4); } } }
            asm volatile("" ::: "memory");
#pragma unroll
            for (int m = 0; m < 4; ++m) { const size_t off = (size_t)(row0 + ai * HALF + m * 16) * 1024 + col;
#pragma unroll
                for (int bj = 0; bj < 2; ++bj) { const f32x4 v0 = bs[m][bj][0] + gv[bj][0] * acc[ai][bj][m][0], v1 = bs[m][bj][1] + gv[bj][1] * acc[ai][bj][m][1];
                    if (OUT_BF16) { u32x4e w; w.x = cvt_pk_bf16(v0[0], v0[1]); w.y = cvt_pk_bf16(v0[2], v0[3]); w.z = cvt_pk_bf16(v1[0], v1[1]); w.w = cvt_pk_bf16(v1[2], v1[3]); *(u32x4e*)((bf16_t*)out + off + 32 * bj) = w; }
                    else { *(f32x4*)((float*)out + off + 32 * bj) = v0; *(f32x4*)((float*)out + off + 32 * bj + 4) = v1; } } }
            asm volatile("" ::: "memory");
        }
    }
};
template <class Epi, class Sched, bool ALIGN_EPI = false, bool SP2 = false>
__device__ __forceinline__ void gemm_phase(PG8_LAS unsigned char* lds, const Gemm g, const Sched& S, const Epi& E, const int wave_) {
    int tid; { int l_; asm volatile("v_mbcnt_lo_u32_b32 %0, -1, 0\n\tv_mbcnt_hi_u32_b32 %0, -1, %0" : "=v"(l_)); tid = wave_ * 64 + l_; }
    const int wid = __builtin_amdgcn_readfirstlane(tid >> 6), lane = tid & 63, wr = wid >> 2, wc = wid & 3, fr = lane & 15, fq = lane >> 4;
    const int K = g.K, nt = K / BK;
    unsigned voffA[2], voffB[2];
#pragma unroll
    for (int i = 0; i < 2; ++i) { int R, C; stage_rc(tid * 16 + i * 8192, R, C); const int Rb = Epi::PERM ? ((R & ~31) + perm32(R & 31)) : R;
        voffA[i] = (unsigned)(R * K + C) * 2u; voffB[i] = (unsigned)(Rb * K + C) * 2u; }
    const size_t kstep = (size_t)(BK * 2);
    const size_t hstep = (size_t)HALF * K * 2;
    const size_t tstep = 2 * hstep;
    const unsigned ldsw = (unsigned)wid * 1024u;
    const int aoff = lds_byte(wr * 64 + fr, fq * 8), boff = lds_byte(wc * 32 + fr, fq * 8);
#define PG8_SA(b, h) (((b) * 2 + (h)) * HTB)
#define PG8_SB(b, h) ((4 + (b) * 2 + (h)) * HTB)
#define PG8_STAGE(bufoff, gbase, voff) do { _Pragma("unroll") for (int _i = 0; _i < 2; ++_i) \
        __builtin_amdgcn_global_load_lds((const unsigned*)((const char*)(gbase) + (voff)[_i]), (PG8_LAS unsigned*)(lds + (bufoff) + ldsw + _i * 8192), 16, 0, 0); } while (0)
#define PG8_LDA(dst, b, h) do { _Pragma("unroll") for (int m = 0; m < 4; ++m) _Pragma("unroll") for (int k = 0; k < 2; ++k) dst[m][k] = *(const PG8_LAS bf16x8*)(lds + PG8_SA(b, h) + aoff + m * 2048 + k * 1024); } while (0)
#define PG8_LDB(dst, b, h) do { _Pragma("unroll") for (int n = 0; n < 2; ++n) _Pragma("unroll") for (int k = 0; k < 2; ++k) dst[n][k] = *(const PG8_LAS bf16x8*)(lds + PG8_SB(b, h) + boff + n * 2048 + k * 1024); } while (0)
#define PG8_MMA(ai, bj, At, Bt) do { __builtin_amdgcn_s_setprio(1); _Pragma("unroll") for (int m = 0; m < 4; ++m) _Pragma("unroll") for (int n = 0; n < 2; ++n) _Pragma("unroll") for (int k = 0; k < 2; ++k) \
        acc[ai][bj][m][n] = __builtin_amdgcn_mfma_f32_16x16x32_bf16(Bt[n][k], At[m][k], acc[ai][bj][m][n], 0, 0, 0); __builtin_amdgcn_s_setprio(0); } while (0)
#define PG8_WAIT_V(n) asm volatile("s_waitcnt vmcnt(" #n ")" ::: "memory")
#define PG8_WAIT_L(n) asm volatile("s_waitcnt lgkmcnt(" #n ")" ::: "memory")
#define PG8_BAR __builtin_amdgcn_s_barrier()
#define PG8_SCHED __builtin_amdgcn_sched_barrier(0)
    Unit cur, nxt; int ui = 0;
    if (!S.next(0, cur)) return;
    f32x4 acc[2][2][4][2];
#pragma unroll
    for (int a = 0; a < 2; ++a)
#pragma unroll
        for (int b = 0; b < 2; ++b)
#pragma unroll
            for (int m = 0; m < 4; ++m)
#pragma unroll
                for (int n = 0; n < 2; ++n) acc[a][b][m][n] = (f32x4){0.f, 0.f, 0.f, 0.f};
    bf16x8 At[4][2], B0[2][2], B1[2][2];
    const char* cA = (const char*)g.A + (size_t)cur.pm * tstep; const char* cB = (const char*)g.Bt + (size_t)cur.pn * tstep + (size_t)(cur.pm >> 5) * g.bstride * 2;
    S.a_ready(cur);
    if constexpr (SP2) {
        PG8_STAGE(PG8_SB(0, 0), cB, voffB); PG8_STAGE(PG8_SB(0, 1), cB + hstep, voffB); PG8_STAGE(PG8_SA(0, 0), cA, voffA); PG8_STAGE(PG8_SA(0, 1), cA + hstep, voffA);
        if (wr == 1) PG8_BAR;
        PG8_WAIT_V(2); PG8_BAR;
        PG8_STAGE(PG8_SB(1, 0), cB + kstep, voffB); PG8_STAGE(PG8_SA(1, 0), cA + kstep, voffA); PG8_STAGE(PG8_SB(1, 1), cB + hstep + kstep, voffB);
        PG8_WAIT_V(6); PG8_BAR;
    } else {
        PG8_STAGE(PG8_SB(0, 0), cB, voffB); PG8_STAGE(PG8_SA(0, 0), cA, voffA); PG8_STAGE(PG8_SB(0, 1), cB + hstep, voffB); PG8_STAGE(PG8_SA(0, 1), cA + hstep, voffA);
        if (wr == 1) PG8_BAR;
        PG8_WAIT_V(4); PG8_BAR;
        PG8_STAGE(PG8_SB(1, 0), cB + kstep, voffB); PG8_STAGE(PG8_SA(1, 0), cA + kstep, voffA); PG8_STAGE(PG8_SB(1, 1), cB + hstep + kstep, voffB);
        PG8_WAIT_V(6); PG8_BAR;
    }
    for (;;) {
        const bool has_next = S.next(ui + 1, nxt);
        const char* nA = has_next ? (const char*)g.A + (size_t)nxt.pm * tstep : cA; const char* nB = has_next ? (const char*)g.Bt + (size_t)nxt.pn * tstep + (size_t)(nxt.pm >> 5) * g.bstride * 2 : cB;
        for (int t = 0; t < nt; t += 2) {
            const bool last = (t == nt - 2);
            const char* a1 = cA + (size_t)(t + 1) * kstep;
            const char* a2 = last ? nA : cA + (size_t)(t + 2) * kstep; const char* b2 = last ? nB : cB + (size_t)(t + 2) * kstep;
            const char* a3 = a2 + kstep; const char* b3 = b2 + kstep;
            if (last && has_next) S.a_ready(nxt);
            if constexpr (SP2) {
            PG8_LDB(B0, 0, 0); PG8_LDB(B1, 0, 1); PG8_SCHED; PG8_LDA(At, 0, 0); PG8_STAGE(PG8_SA(1, 1), a1 + hstep, voffA);
            PG8_WAIT_V(8); PG8_WAIT_L(0); PG8_BAR; PG8_MMA(0, 0, At, B0); PG8_MMA(0, 1, At, B1); PG8_BAR; PG8_SCHED;
            PG8_LDA(At, 0, 1); PG8_STAGE(PG8_SB(0, 0), b2, voffB); PG8_STAGE(PG8_SB(0, 1), b2 + hstep, voffB); PG8_STAGE(PG8_SA(0, 0), a2, voffA);
            PG8_WAIT_V(8); PG8_WAIT_L(0); PG8_BAR; PG8_MMA(1, 0, At, B0); PG8_MMA(1, 1, At, B1); PG8_BAR; PG8_SCHED;
            PG8_LDB(B0, 1, 0); PG8_LDB(B1, 1, 1); PG8_SCHED; PG8_LDA(At, 1, 0); PG8_STAGE(PG8_SA(0, 1), a2 + hstep, voffA);
            PG8_WAIT_V(8); PG8_WAIT_L(0); PG8_BAR; PG8_MMA(0, 0, At, B0); PG8_MMA(0, 1, At, B1); PG8_BAR; PG8_SCHED;
            PG8_LDA(At, 1, 1); PG8_STAGE(PG8_SB(1, 0), b3, voffB); PG8_STAGE(PG8_SB(1, 1), b3 + hstep, voffB); PG8_STAGE(PG8_SA(1, 0), a3, voffA);
            PG8_WAIT_V(8); PG8_WAIT_L(0); PG8_BAR; PG8_MMA(1, 0, At, B0); PG8_MMA(1, 1, At, B1); PG8_BAR; PG8_SCHED;
            } else {
            PG8_LDB(B0, 0, 0); PG8_SCHED; PG8_LDA(At, 0, 0); PG8_STAGE(PG8_SA(1, 1), a1 + hstep, voffA);
            PG8_WAIT_L(8); PG8_BAR; PG8_WAIT_L(0); PG8_MMA(0, 0, At, B0); PG8_BAR; PG8_SCHED;
            PG8_LDB(B1, 0, 1); PG8_STAGE(PG8_SB(0, 0), b2, voffB);
            PG8_BAR; PG8_WAIT_L(0); PG8_MMA(0, 1, At, B1); PG8_BAR;
            PG8_LDA(At, 0, 1); PG8_STAGE(PG8_SA(0, 0), a2, voffA);
            PG8_BAR; PG8_WAIT_L(0); PG8_MMA(1, 0, At, B0); PG8_BAR; PG8_SCHED;
            PG8_STAGE(PG8_SB(0, 1), b2 + hstep, voffB);
            PG8_WAIT_V(6); PG8_BAR; PG8_MMA(1, 1, At, B1); PG8_BAR;
            PG8_LDB(B0, 1, 0); PG8_SCHED; PG8_LDA(At, 1, 0); PG8_STAGE(PG8_SA(0, 1), a2 + hstep, voffA);
            PG8_WAIT_L(8); PG8_BAR; PG8_WAIT_L(0); PG8_MMA(0, 0, At, B0); PG8_BAR; PG8_SCHED;
            PG8_LDB(B1, 1, 1); PG8_STAGE(PG8_SB(1, 0), b3, voffB);
            PG8_BAR; PG8_WAIT_L(0); PG8_MMA(0, 1, At, B1); PG8_BAR;
            PG8_LDA(At, 1, 1); PG8_STAGE(PG8_SA(1, 0), a3, voffA);
            PG8_BAR; PG8_WAIT_L(0); PG8_MMA(1, 0, At, B0); PG8_BAR; PG8_SCHED;
            PG8_STAGE(PG8_SB(1, 1), b3 + hstep, voffB);
            PG8_WAIT_V(6); PG8_BAR; PG8_MMA(1, 1, At, B1); PG8_BAR;
            }
        }
        if constexpr (ALIGN_EPI) { if (wr == 0) PG8_BAR; }
        if constexpr (!Epi::AFTER_DRAIN) { E(acc, cur, wr, wc, fr, fq); S.done(cur); }
        if (!has_next) break;
#pragma unroll
        for (int a = 0; a < 2; ++a)
#pragma unroll
            for (int b = 0; b < 2; ++b)
#pragma unroll
                for (int m = 0; m < 4; ++m)
#pragma unroll
                    for (int n = 0; n < 2; ++n) acc[a][b][m][n] = (f32x4){0.f, 0.f, 0.f, 0.f};
        cur = nxt; cA = nA; cB = nB; ++ui;
        if constexpr (ALIGN_EPI) { if (wr == 1) PG8_BAR; }
    }
    PG8_WAIT_V(0);
    if constexpr (!ALIGN_EPI) { if (wr == 0) PG8_BAR; }
    PG8_BAR;
    if constexpr (Epi::AFTER_DRAIN) { E.fused(acc, cur, wr, wc, fr, fq, lds, wid, lane); S.done(cur); }
#undef PG8_SA
#undef PG8_SB
#undef PG8_STAGE
#undef PG8_LDA
#undef PG8_LDB
#undef PG8_MMA
#undef PG8_WAIT_V
#undef PG8_WAIT_L
#undef PG8_BAR
#undef PG8_SCHED
}
}
constexpr int BATCH = 8, SEQ = 8192, DM = 1024, MROWS = BATCH * SEQ;
constexpr float LOG2E = 1.4426950408889634f;
constexpr size_t MiB = 1u << 20;
constexpr size_t WS_CTL = 0, WS_MOD = 1 * MiB, WS_WINA = 2 * MiB, WS_WOUTA = 10 * MiB, WS_WKV = 12 * MiB, WS_WINB = 13 * MiB, WS_WOUTB = 17 * MiB;
constexpr size_t WS_R0 = 32 * MiB, WS_R1 = 160 * MiB, WS_R2 = 288 * MiB, WS_R3 = 416 * MiB, WS_R4 = 544 * MiB, WS_H = 672 * MiB, WS_END = 928 * MiB;
constexpr int LDS_BYTES = 147456;
constexpr int NTHREADS = 512;

#define LAS __attribute__((address_space(3)))
typedef unsigned short bf16_t;
typedef short bf16x8 __attribute__((ext_vector_type(8)));
typedef short s16x4 __attribute__((ext_vector_type(4)));
typedef float f32x4 __attribute__((ext_vector_type(4)));
typedef float f32x16 __attribute__((ext_vector_type(16)));
typedef unsigned u32x4 __attribute__((ext_vector_type(4)));
typedef unsigned u32x2 __attribute__((ext_vector_type(2)));
typedef LAS const unsigned char* lds_cptr;

__device__ __forceinline__ unsigned cvtpk(float lo, float hi) { unsigned r; asm("v_cvt_pk_bf16_f32 %0, %1, %2" : "=v"(r) : "v"(lo), "v"(hi)); return r; }
__device__ __forceinline__ float bf_lo(unsigned w) { return __uint_as_float(w << 16); }
__device__ __forceinline__ float bf_hi(unsigned w) { return __uint_as_float(w & 0xffff0000u); }
__device__ __forceinline__ float wave_sum(float v) {
#pragma unroll
    for (int o = 1; o < 64; o <<= 1) v += __shfl_xor(v, o);
    return v;
}
__device__ __forceinline__ float half_swap_max(float m) { auto rr = __builtin_amdgcn_permlane32_swap(__float_as_uint(m), __float_as_uint(m), false, false); return fmaxf(__uint_as_float(rr[0]), __uint_as_float(rr[1])); }
__device__ __forceinline__ float half_swap_sum(float m) { auto rr = __builtin_amdgcn_permlane32_swap(__float_as_uint(m), __float_as_uint(m), false, false); return __uint_as_float(rr[0]) + __uint_as_float(rr[1]); }
__device__ __forceinline__ int my_tid(int wave) { int l_; asm volatile("v_mbcnt_lo_u32_b32 %0, -1, 0\n\tv_mbcnt_hi_u32_b32 %0, -1, %0" : "=v"(l_)); return wave * 64 + l_; }
#define XB_TMO      128
#define XB_XCNT(j)  (256  + 64 * (j))
#define XB_XSUB(j)  (1280 + 64 * (j))
#define XB_XGEN(j)  (2304 + 64 * (j))
#define XB_TOP      3328
#define XB_TOPGEN   3392
#define XCD_BAR_WORDS 3456
#define XB_SPIN_CAP (1u << 23)
__device__ __forceinline__ unsigned xb_ld(unsigned* p)              { return __hip_atomic_load(p, __ATOMIC_RELAXED, __HIP_MEMORY_SCOPE_AGENT); }
__device__ __forceinline__ unsigned xb_add(unsigned* p, unsigned v) { return __hip_atomic_fetch_add(p, v, __ATOMIC_RELAXED, __HIP_MEMORY_SCOPE_AGENT); }
#define XB_SPIN(cond, bar) do { unsigned _sp = 0; while (cond) { __builtin_amdgcn_s_sleep(1); \
    if ((++_sp & 255u) == 0u) { if (xb_ld(&(bar)[XB_TMO])) break; if (_sp > XB_SPIN_CAP) { atomicAdd(&(bar)[XB_TMO], 1u); break; } } } } while (0)
__device__ __forceinline__ void grid_bar(unsigned* bar, const unsigned x, volatile LAS unsigned* st, int wave) {
    asm volatile("s_waitcnt vmcnt(0)" ::: "memory");
    __syncthreads();
    if (my_tid(wave) == 0) {
        __builtin_amdgcn_s_waitcnt(0);
        unsigned nloc = st[0], nx = st[1];
        if (nloc == 0u) {
            const unsigned G_ = gridDim.x; unsigned sum, cnt, mine, sp = 0u;
            for (;;) {
                sum = 0u; cnt = 0u; mine = 0u;
#pragma unroll
                for (unsigned jx = 0; jx < 16; ++jx) { const unsigned c_ = xb_ld(&bar[XB_XCNT(jx)]); sum += c_; cnt += (c_ > 0u) ? 1u : 0u; mine = (jx == x) ? c_ : mine; }
                if (sum == G_) break;
                __builtin_amdgcn_s_sleep(1);
                if ((++sp & 255u) == 0u) { if (xb_ld(&bar[XB_TMO])) break; if (sp > XB_SPIN_CAP) { atomicAdd(&bar[XB_TMO], 1u); break; } }
            }
            nloc = mine > 0u ? mine : 1u; nx = cnt > 0u ? cnt : 1u; st[0] = nloc; st[1] = nx;
        }
        const unsigned old = xb_add(&bar[XB_XSUB(x)], 1u);
        const unsigned gen = old / nloc;
        if (old + 1u == (gen + 1u) * nloc) {
            __builtin_amdgcn_fence(__ATOMIC_RELEASE, "agent");
            asm volatile("s_waitcnt vmcnt(0)" ::: "memory");
            const unsigned og = xb_add(&bar[XB_TOP], 1u);
            const unsigned tg = og / nx;
            if (og + 1u == (tg + 1u) * nx) xb_add(&bar[XB_TOPGEN], 1u);
            else XB_SPIN(xb_ld(&bar[XB_TOPGEN]) == tg, bar);
            __builtin_amdgcn_fence(__ATOMIC_ACQUIRE, "agent");
            xb_add(&bar[XB_XGEN(x)], 1u);
            asm volatile("s_waitcnt vmcnt(0)" ::: "memory");
        } else {
            XB_SPIN(xb_ld(&bar[XB_XGEN(x)]) == gen, bar);
            __builtin_amdgcn_fence(__ATOMIC_ACQUIRE, "agent");
            asm volatile("s_waitcnt vmcnt(0)" ::: "memory");
        }
    }
    __syncthreads();
}
__device__ __forceinline__ int crow(int r, int hi) { return (r & 3) + 8 * (r >> 2) + 4 * hi; }
__device__ __forceinline__ void glds16(const void* g, unsigned lds_base) {
    unsigned sv; asm volatile("s_mov_b32 %0, m0\n\ts_mov_b32 m0, %2\n\ts_nop 0\n\tglobal_load_lds_dwordx4 %1, off\n\ts_mov_b32 m0, %0" : "=&s"(sv) : "v"(g), "s"(lds_base) : "memory"); }
#define GLDS(g, dst) glds16((g), (unsigned)__builtin_amdgcn_readfirstlane((int)(dst)))
#define WAIT_BAR(N) asm volatile("s_waitcnt vmcnt(" #N ") lgkmcnt(0)\n\ts_barrier" ::: "memory")
#define LDS_WAIT() asm volatile("s_waitcnt lgkmcnt(0)" ::: "memory")
typedef short v4i16_t __attribute__((ext_vector_type(4)));
__device__ __forceinline__ s16x4 vtr(lds_cptr p) { return __builtin_bit_cast(s16x4, __builtin_amdgcn_ds_read_tr16_b64_v4i16((LAS v4i16_t*)p)); }
#define MFMA32(a, b, c) __builtin_amdgcn_mfma_f32_32x32x16_bf16((a), (b), (c), 0, 0, 0)

__device__ __forceinline__ void pack_p(bf16x8 (&pf)[4], const f32x16& p0, const f32x16& p1) {
    u32x4 w;
    w.x = cvtpk(p0[0], p0[1]); w.y = cvtpk(p0[2], p0[3]); w.z = cvtpk(p0[4], p0[5]); w.w = cvtpk(p0[6], p0[7]); pf[0] = __builtin_bit_cast(bf16x8, w);
    w.x = cvtpk(p0[8], p0[9]); w.y = cvtpk(p0[10], p0[11]); w.z = cvtpk(p0[12], p0[13]); w.w = cvtpk(p0[14], p0[15]); pf[1] = __builtin_bit_cast(bf16x8, w);
    w.x = cvtpk(p1[0], p1[1]); w.y = cvtpk(p1[2], p1[3]); w.z = cvtpk(p1[4], p1[5]); w.w = cvtpk(p1[6], p1[7]); pf[2] = __builtin_bit_cast(bf16x8, w);
    w.x = cvtpk(p1[8], p1[9]); w.y = cvtpk(p1[10], p1[11]); w.z = cvtpk(p1[12], p1[13]); w.w = cvtpk(p1[14], p1[15]); pf[3] = __builtin_bit_cast(bf16x8, w);
}
constexpr int ASLOT = 32768;
__device__ __forceinline__ void attnA_unit(const int wave_, LAS unsigned char* lds, unsigned lds0, const int s0, const int pre, LAS int* nextw, const LAS int* cuts, const LAS int* utab, unsigned* qheads, const int xcc, bf16x8 (&qio)[4],
                                           int b, int h, int qb, int t_lo, float smax2,
                                           const bf16_t* QA, const bf16_t* KA, const bf16_t* VA, const bf16_t* ZA, bf16_t* OA, const float* subg, float lam) {
    const int tid = my_tid(wave_);
    const int lane = tid & 63, r32 = lane & 31, hi = lane >> 5;
    const int wid = wave_, j = wid >> 2, wq = wid & 3;
    const int q0 = qb * 128, NT = (q0 + 128) / 64 - t_lo;
    const size_t rowbase = (size_t)b * SEQ;
    const int qloc = 32 * wq + r32, qpos = q0 + qloc;
    const float slope2 = exp2f(-(float)(h + 1)) * LOG2E;
    bf16x8 qf[4];
    if (pre) {
#pragma unroll
        for (int d0 = 0; d0 < 4; ++d0) qf[d0] = qio[d0];
    } else { const bf16_t* Qw = QA + (rowbase + qpos) * 1024 + (2 * h + j) * 64 + hi * 8;
#pragma unroll
      for (int d0 = 0; d0 < 4; ++d0) qf[d0] = *(const bf16x8*)(Qw + d0 * 16); }
    const int krow = 8 * wid + (lane >> 3), kch = (lane & 7) ^ ((krow >> 1) & 7);
    const bf16_t* ksrc0 = KA + ((size_t)(b * 16 + 2 * h) * SEQ + krow) * 64 + kch * 8;
    const int pva = 2 * wid, pvb = 2 * wid + 1, vch = (lane & 15) ^ (((lane >> 4) & 3) << 2);
    const bf16_t* vsrcA = VA + ((size_t)(b * 8 + h) * SEQ + 4 * pva + (lane >> 4)) * 128 + vch * 8;
    const bf16_t* vsrcB = vsrcA + 4 * 128;
    const int klane = krow * 64 + kch * 8, vlane = (4 * pva + (lane >> 4)) * 128 + vch * 8;
    const unsigned kdst = lds0 + wid * 1024, vdstA = lds0 + 16384 + pva * 1024, vdstB = lds0 + 16384 + pvb * 1024;
#define DMA_TILE(t, sl) do { const size_t ko_ = (size_t)(t) * 64 * 64, vo_ = (size_t)(t) * 64 * 128; const unsigned so_ = (unsigned)(sl) * ASLOT; \
        GLDS(ksrc0 + ko_, kdst + so_); GLDS(ksrc0 + (size_t)SEQ * 64 + ko_, kdst + 8192 + so_); GLDS(vsrcA + vo_, vdstA + so_); GLDS(vsrcB + vo_, vdstB + so_); } while (0)
    asm volatile("" ::: "memory");
    if (!pre) { DMA_TILE(t_lo, s0);
        if (NT > 1) DMA_TILE(t_lo + 1, s0 + 1); }
    if (NT > 2) DMA_TILE(t_lo + 2, (s0 + 2) & 3);
    f32x16 bias0;
#pragma unroll
    for (int r = 0; r < 16; ++r) bias0[r] = slope2 * (float)(crow(r, hi) - qloc);
    const float s32 = 32.f * slope2;
    float l = 0.f;
    f32x16 o[4];
#pragma unroll
    for (int db = 0; db < 4; ++db)
#pragma unroll
        for (int r = 0; r < 16; ++r) o[db][r] = 0.f;
    const int kofs = j * 8192 + r32 * 128;
    const int kx0 = (hi ^ ((r32 >> 1) & 7)) * 16;
    const int vx0 = 256 * (4 * hi + ((lane & 15) >> 2)) + 16 * (4 * ((lane >> 2) & 3) + 2 * ((lane >> 4) & 1) + ((lane >> 1) & 1)) + 8 * (lane & 1);
    const int qfirst = q0 + 32 * wq, qlast = qfirst + 31;
    const int NTw = (64 * (t_lo + NT - 1) <= qlast) ? NT : NT - 1;
    f32x16 p0, p1;
#define SB0() __builtin_amdgcn_sched_barrier(0)
#define PINV(x) asm volatile("" : "+v"(x))
#define KLD(kf, sl, d0) do { const lds_cptr kb_ = (lds_cptr)lds + (sl) * ASLOT + kofs + (kx0 ^ (32 * (d0))); kf[0] = *(const LAS bf16x8*)(kb_); kf[1] = *(const LAS bf16x8*)(kb_ + 4096); } while (0)
    struct VF1 { s16x4 lo, hh; };
#define VLD1(vf, sl, g_) do { const lds_cptr vb_ = (lds_cptr)lds + (sl) * ASLOT + 16384 + (vx0 ^ (64 * ((g_) >> 2))) + ((g_) & 3) * 4096; vf.lo = vtr(vb_); vf.hh = vtr(vb_ + 2048); } while (0)
#define VF8(vf) ((bf16x8){vf.lo[0], vf.lo[1], vf.lo[2], vf.lo[3], vf.hh[0], vf.hh[1], vf.hh[2], vf.hh[3]})
#define QK8(sl) do { bf16x8 ka[2], kb2[2], kc[2], kd[2]; \
        KLD(ka, sl, 0); KLD(kb2, sl, 1); KLD(kc, sl, 2); KLD(kd, sl, 3); SB0(); \
        p0 = MFMA32(ka[0], qf[0], bias0); p1 = MFMA32(ka[1], qf[0], bias0); p0 = MFMA32(kb2[0], qf[1], p0); p1 = MFMA32(kb2[1], qf[1], p1); \
        p0 = MFMA32(kc[0], qf[2], p0); p1 = MFMA32(kc[1], qf[2], p1); p0 = MFMA32(kd[0], qf[3], p0); p1 = MFMA32(kd[1], qf[3], p1); SB0(); } while (0)
#define KLOADS(sl) bf16x8 ka[2], kb2[2], kc[2], kd[2]; KLD(ka, sl, 0); KLD(kb2, sl, 1); KLD(kc, sl, 2); KLD(kd, sl, 3); SB0()
#define QKMMA() do { p0 = MFMA32(ka[0], qf[0], bias0); p1 = MFMA32(ka[1], qf[0], bias0); p0 = MFMA32(kb2[0], qf[1], p0); p1 = MFMA32(kb2[1], qf[1], p1); \
        p0 = MFMA32(kc[0], qf[2], p0); p1 = MFMA32(kc[1], qf[2], p1); p0 = MFMA32(kd[0], qf[3], p0); p1 = MFMA32(kd[1], qf[3], p1); SB0(); } while (0)
#define MASK(t) do { if (64 * (t) + 63 > qfirst) { const int qh = qpos - 64 * (t) - 4 * hi; \
            _Pragma("unroll") for (int r = 0; r < 16; ++r) { const int cr = (r & 3) + 8 * (r >> 2); if (cr > qh) p0[r] = -INFINITY; if (cr + 32 > qh) p1[r] = -INFINITY; } SB0(); } } while (0)
    u32x4 pc0, pc1, pc2, pc3;
    if (NT > 2) { WAIT_BAR(4); } else { WAIT_BAR(0); }
    int pend = 1 << 20; if (tid == 0) pend = (int)atomicAdd(qheads + 64 * b, 1u);
    QK8(s0); MASK(t_lo);
    { const float c0 = slope2 * (float)(64 * t_lo - q0) - smax2, c1 = c0 + s32; float rs = 0.f;
#pragma unroll
      for (int r = 0; r < 16; ++r) { p0[r] = __builtin_amdgcn_exp2f(p0[r] + c0); p1[r] = __builtin_amdgcn_exp2f(p1[r] + c1); rs += p0[r] + p1[r]; }
      l += rs;
      pc0 = (u32x4){cvtpk(p0[0], p0[1]), cvtpk(p0[2], p0[3]), cvtpk(p0[4], p0[5]), cvtpk(p0[6], p0[7])};
      pc1 = (u32x4){cvtpk(p0[8], p0[9]), cvtpk(p0[10], p0[11]), cvtpk(p0[12], p0[13]), cvtpk(p0[14], p0[15])};
      pc2 = (u32x4){cvtpk(p1[0], p1[1]), cvtpk(p1[2], p1[3]), cvtpk(p1[4], p1[5]), cvtpk(p1[6], p1[7])};
      pc3 = (u32x4){cvtpk(p1[8], p1[9]), cvtpk(p1[10], p1[11]), cvtpk(p1[12], p1[13]), cvtpk(p1[14], p1[15])}; SB0(); }
    for (int i = 0; i + 1 < NTw; ++i) {
        const int t = t_lo + i;
        if (i + 2 < NT) { WAIT_BAR(4); } else { WAIT_BAR(0); }
        {
            const int sv = (i + s0) & 3;
            KLOADS((i + 1 + s0) & 3);
            VF1 vcur, vn1; VLD1(vcur, sv, 0); VLD1(vn1, sv, 1); SB0();
            if (i + 3 < NT) DMA_TILE(t + 3, (i + 3 + s0) & 3);
            const bf16x8 q0_ = __builtin_bit_cast(bf16x8, pc0), q1_ = __builtin_bit_cast(bf16x8, pc1), q2_ = __builtin_bit_cast(bf16x8, pc2), q3_ = __builtin_bit_cast(bf16x8, pc3);
            SB0();
            QKMMA(); MASK(t + 1);
            const float c0 = slope2 * (float)(64 * (t + 1) - q0) - smax2, c1 = c0 + s32; float rs = 0.f;
            u32x4 n0, n1, n2, n3;
#pragma unroll
            for (int g = 0; g < 16; ++g) {
                VF1 vn2; if (g < 14) VLD1(vn2, sv, g + 2);
                const bf16x8 pk_ = (g & 3) == 0 ? q0_ : (g & 3) == 1 ? q1_ : (g & 3) == 2 ? q2_ : q3_;
                o[g >> 2] = MFMA32(VF8(vcur), pk_, o[g >> 2]);
                p0[g] = __builtin_amdgcn_exp2f(p0[g] + c0); p1[g] = __builtin_amdgcn_exp2f(p1[g] + c1); rs += p0[g] + p1[g];
                PINV(p0[g]); PINV(p1[g]); PINV(rs);
                if (g & 1) { const unsigned wa = cvtpk(p0[g - 1], p0[g]), wb = cvtpk(p1[g - 1], p1[g]); const int k = g >> 1;
                    if (k < 4) { n0[k & 3] = wa; n2[k & 3] = wb; } else { n1[k & 3] = wa; n3[k & 3] = wb; } }
                SB0();
                vcur = vn1; if (g < 14) vn1 = vn2;
            }
            l += rs;
            pc0 = n0; pc1 = n1; pc2 = n2; pc3 = n3;
        }
    }
    {
        const int i = NTw - 1;
        if (i + 2 < NT) { WAIT_BAR(4); } else { WAIT_BAR(0); }
        if (i + 3 < NT) DMA_TILE(t_lo + i + 3, (i + 3 + s0) & 3);
        const int sv = (i + s0) & 3;
        const bf16x8 q0_ = __builtin_bit_cast(bf16x8, pc0), q1_ = __builtin_bit_cast(bf16x8, pc1), q2_ = __builtin_bit_cast(bf16x8, pc2), q3_ = __builtin_bit_cast(bf16x8, pc3);
        VF1 vcur; VLD1(vcur, sv, 0);
#pragma unroll
        for (int g = 0; g < 16; ++g) {
            VF1 vnx; if (g < 15) VLD1(vnx, sv, g + 1);
            const bf16x8 pk_ = (g & 3) == 0 ? q0_ : (g & 3) == 1 ? q1_ : (g & 3) == 2 ? q2_ : q3_;
            o[g >> 2] = MFMA32(VF8(vcur), pk_, o[g >> 2]);
            SB0();
            if (g < 15) vcur = vnx;
        }
    }
    if (NTw < NT) { WAIT_BAR(0); }
#undef KLD
#undef VLD1
#undef VF8
#undef QK8
#undef KLOADS
#undef QKMMA
#undef MASK
#undef PINV
#undef DMA_TILE
    l = half_swap_sum(l);
    const float rl = 1.0f / l;
    if (my_tid(wave_) == 0) {
        int d_ = -1;
        if (pend < 512) d_ = (b << 16) | utab[pend];
        else for (int qi_ = ((b - xcc) & 7) + 1; qi_ < 8; ++qi_) { const int bq_ = (xcc + qi_) & 7; const int ix_ = (int)atomicAdd(qheads + 64 * bq_, 1u); if (ix_ < 512) { d_ = (bq_ << 16) | utab[ix_]; break; } }
        *nextw = d_;
    }
    WAIT_BAR(0);
    const int lane2 = my_tid(wave_) & 63, hi2 = lane2 >> 5;
    {
        const int nd = *nextw;
        if (nd >= 0) {
            const int nb = nd >> 16, nh = (nd >> 6) & 7, nqb = nd & 63, ndd = nqb * 128 - cuts[nh], ntl = ndd > 0 ? ndd >> 6 : 0, nNT = 2 * nqb + 2 - ntl;
            const bf16_t* nk = KA + (size_t)(nb * 16 + 2 * nh) * SEQ * 64 + klane + (size_t)ntl * 64 * 64;
            const bf16_t* nv = VA + (size_t)(nb * 8 + nh) * SEQ * 128 + vlane + (size_t)ntl * 64 * 128;
            const unsigned so_ = (unsigned)(s0 ^ 2) * ASLOT;
            GLDS(nk, kdst + so_); GLDS(nk + (size_t)SEQ * 64, kdst + 8192 + so_); GLDS(nv, vdstA + so_); GLDS(nv + 4 * 128, vdstB + so_);
            if (nNT > 1) { GLDS(nk + 64 * 64, kdst + so_ + ASLOT); GLDS(nk + (size_t)SEQ * 64 + 64 * 64, kdst + 8192 + so_ + ASLOT); GLDS(nv + 64 * 128, vdstA + so_ + ASLOT); GLDS(nv + 64 * 128 + 4 * 128, vdstB + so_ + ASLOT); }
            const bf16_t* Qn = QA + ((size_t)nb * SEQ + nqb * 128 + 32 * wq + (lane2 & 31)) * 1024 + (2 * nh + j) * 64 + hi2 * 8;
#pragma unroll
            for (int d0 = 0; d0 < 4; ++d0) qio[d0] = *(const bf16x8*)(Qn + d0 * 16);
        }
    }
    LAS float* xch = (LAS float*)(lds + s0 * ASLOT) + wq * 4096 + lane2;
    if (j == 1) {
#pragma unroll
        for (int db = 0; db < 4; ++db)
#pragma unroll
            for (int r = 0; r < 16; ++r) xch[(db * 16 + r) * 64] = o[db][r] * rl;
    }
    WAIT_BAR(0);
    if (j == 0) {
        float ss = 0.f;
#pragma unroll
        for (int db = 0; db < 4; ++db) {
            SB0();
#pragma unroll
            for (int r = 0; r < 16; ++r) { const float v = o[db][r] * rl - lam * xch[(db * 16 + r) * 64]; o[db][r] = v; ss += v * v; }
        }
        ss = half_swap_sum(ss);
        const float rstd = rsqrtf(ss * (1.0f / 128.0f) + 1e-6f) * 0.8f;
        const size_t rowoff = ((size_t)b * SEQ + q0 + 32 * wq + (lane2 & 31)) * 1024 + h * 128;
#pragma unroll
        for (int db = 0; db < 4; ++db) {
            SB0();
#pragma unroll
            for (int rg = 0; rg < 4; ++rg) {
                const int d = 32 * db + 8 * rg + 4 * hi2;
                const f32x4 g = *(const f32x4*)(subg + d);
                const u32x2 zz = *(const u32x2*)(ZA + rowoff + d);
                const float v0 = o[db][4 * rg + 0] * rstd * g[0] * bf_lo(zz.x), v1 = o[db][4 * rg + 1] * rstd * g[1] * bf_hi(zz.x);
                const float v2 = o[db][4 * rg + 2] * rstd * g[2] * bf_lo(zz.y), v3 = o[db][4 * rg + 3] * rstd * g[3] * bf_hi(zz.y);
                u32x2 w; w.x = cvtpk(v0, v1); w.y = cvtpk(v2, v3);
                *(u32x2*)(OA + rowoff + d) = w;
            }
        }
    }
    WAIT_BAR(0);
}

__device__ __forceinline__ void attnB_stage(const int wave_, const int lane, unsigned bufaddr, int b, int kvh, int nb, const bf16_t* KVS) {
    const int krow = 8 * wave_ + (lane >> 3), kch = (lane & 7) ^ ((krow >> 1) & 7), vch = (lane & 7) ^ (((krow >> 1) & 1) << 2);
    const long row0 = (long)b * SEQ + 128L * (nb - 1) + krow;
    const bf16_t* ksrc = KVS + row0 * 256 + kvh * 64 + kch * 8;
    const bf16_t* vsrc = KVS + row0 * 256 + 128 + kvh * 64 + vch * 8;
    for (int bt = (nb == 0 ? 2 : 0); bt < 4; ++bt) { GLDS(ksrc + (size_t)bt * 64 * 256, bufaddr + bt * 16384 + wave_ * 1024); GLDS(vsrc + (size_t)bt * 64 * 256, bufaddr + bt * 16384 + 8192 + wave_ * 1024); }
}
__device__ __forceinline__ void attnB_unit(const int wave_, LAS unsigned char* buf, int b, int kvh, int nb, float smax2,
                                           const bf16_t* QB, const bf16_t* ZB, bf16_t* OB, const float* sinks) {
    const int tid = my_tid(wave_);
    const int lane = tid & 63, r32 = lane & 31, hi = lane >> 5;
    const int hq = kvh * 8 + wave_;
    const size_t rowbase = (size_t)b * SEQ;
    const float slope2 = exp2f(-0.5f * (float)(hq + 1)) * LOG2E, sink2 = sinks[hq] * LOG2E;
    const float ref = fmaxf(smax2, sink2), psink = __builtin_amdgcn_exp2f(sink2 - ref);
    const int bt0 = nb == 0 ? 2 : 0;
    const int kx0 = r32 * 128 + (hi ^ ((r32 >> 1) & 7)) * 16;
    const int rq = (lane & 15) >> 2;
    const int vx0 = 8192 + 128 * (4 * hi + rq) + 64 * (rq >> 1) + 32 * ((lane >> 4) & 1) + 8 * (lane & 3);
    const int qh = r32 - 4 * hi;
    f32x16 biasB;
#pragma unroll
    for (int r = 0; r < 16; ++r) biasB[r] = slope2 * (float)((r & 3) + 8 * (r >> 2));
    bf16x8 qf[4], qn[4];
    { const bf16_t* Qp = QB + (rowbase + nb * 128 + r32) * 1024 + hq * 64 + hi * 8;
#pragma unroll
      for (int d0 = 0; d0 < 4; ++d0) qf[d0] = *(const bf16x8*)(Qp + d0 * 16); }
    for (int rb = 0; rb < 4; ++rb) {
        const size_t rowoff = (rowbase + nb * 128 + 32 * rb + r32) * 1024 + hq * 64;
        if (rb < 3) {
#pragma unroll
            for (int d0 = 0; d0 < 4; ++d0) qn[d0] = *(const bf16x8*)(QB + rowoff + 32 * 1024 + d0 * 16 + hi * 8);
        }
        u32x2 zz[2][4];
#pragma unroll
        for (int db = 0; db < 2; ++db)
#pragma unroll
            for (int rg = 0; rg < 4; ++rg) zz[db][rg] = *(const u32x2*)(ZB + rowoff + 32 * db + 8 * rg + 4 * hi);
        float l = hi == 0 ? psink : 0.0f;
        f32x16 o[2];
#pragma unroll
        for (int db = 0; db < 2; ++db)
#pragma unroll
            for (int r = 0; r < 16; ++r) o[db][r] = 0.f;
        for (int tt = 0; tt < 3; ++tt) {
            const int bt = (rb >> 1) + tt;
            if (bt < bt0) continue;
            const lds_cptr tb = (lds_cptr)buf + bt * 16384;
            f32x16 p0, p1;
            { bf16x8 ka[2], kb2[2], kc[2], kd[2];
              ka[0] = *(const LAS bf16x8*)(tb + kx0); ka[1] = *(const LAS bf16x8*)(tb + kx0 + 4096);
              kb2[0] = *(const LAS bf16x8*)(tb + (kx0 ^ 32)); kb2[1] = *(const LAS bf16x8*)(tb + (kx0 ^ 32) + 4096);
              kc[0] = *(const LAS bf16x8*)(tb + (kx0 ^ 64)); kc[1] = *(const LAS bf16x8*)(tb + (kx0 ^ 64) + 4096);
              kd[0] = *(const LAS bf16x8*)(tb + (kx0 ^ 96)); kd[1] = *(const LAS bf16x8*)(tb + (kx0 ^ 96) + 4096);
              __builtin_amdgcn_sched_barrier(0);
              p0 = MFMA32(ka[0], qf[0], biasB); p1 = MFMA32(ka[1], qf[0], biasB); p0 = MFMA32(kb2[0], qf[1], p0); p1 = MFMA32(kb2[1], qf[1], p1);
              p0 = MFMA32(kc[0], qf[2], p0); p1 = MFMA32(kc[1], qf[2], p1); p0 = MFMA32(kd[0], qf[3], p0); p1 = MFMA32(kd[1], qf[3], p1);
              __builtin_amdgcn_sched_barrier(0); }
            s16x4 lo_, hh_, lo1_, hh1_;
            lo_ = vtr(tb + vx0); hh_ = vtr(tb + vx0 + 1024); lo1_ = vtr(tb + vx0 + 2048); hh1_ = vtr(tb + vx0 + 2048 + 1024);
            __builtin_amdgcn_sched_barrier(0);
            const int D0 = 128 + 32 * rb - 64 * bt;
            const float c0 = -slope2 * (float)(D0 + qh) - ref, c1 = c0 + 32.f * slope2;
            float rs = 0.f;
#pragma unroll
            for (int r = 0; r < 16; ++r) { p0[r] = __builtin_amdgcn_exp2f(p0[r] + c0); p1[r] = __builtin_amdgcn_exp2f(p1[r] + c1); }
#define MASKH(P, Dn) do { if ((Dn) == 128) { _Pragma("unroll") for (int r = 0; r < 16; ++r) { const int cr = (r & 3) + 8 * (r >> 2); if (!(cr > qh)) P[r] = 0.f; } } \
                else if ((Dn) == 0) { _Pragma("unroll") for (int r = 0; r < 16; ++r) { const int cr = (r & 3) + 8 * (r >> 2); if (cr > qh) P[r] = 0.f; } } \
                else if ((Dn) < 0 || (Dn) > 128) { _Pragma("unroll") for (int r = 0; r < 16; ++r) P[r] = 0.f; } } while (0)
            MASKH(p0, D0); MASKH(p1, D0 - 32);
#undef MASKH
#pragma unroll
            for (int r = 0; r < 16; ++r) rs += p0[r] + p1[r];
            l += rs;
            bf16x8 pf[4]; pack_p(pf, p0, p1);
            __builtin_amdgcn_sched_barrier(0);
            {
                s16x4 lo2_, hh2_;
#pragma unroll
                for (int g = 0; g < 8; ++g) {
                    if (g < 6) { const int g2 = g + 2; lo2_ = vtr(tb + (vx0 ^ (64 * (g2 >> 2))) + (g2 & 3) * 2048); hh2_ = vtr(tb + (vx0 ^ (64 * (g2 >> 2))) + (g2 & 3) * 2048 + 1024); }
                    const bf16x8 vf = (bf16x8){lo_[0], lo_[1], lo_[2], lo_[3], hh_[0], hh_[1], hh_[2], hh_[3]};
                    o[g >> 2] = MFMA32(vf, pf[g & 3], o[g >> 2]);
                    __builtin_amdgcn_sched_barrier(0);
                    lo_ = lo1_; hh_ = hh1_; if (g < 6) { lo1_ = lo2_; hh1_ = hh2_; }
                }
            }
        }
        l = half_swap_sum(l);
        const float rl = 1.0f / l;
#pragma unroll
        for (int db = 0; db < 2; ++db)
#pragma unroll
            for (int rg = 0; rg < 4; ++rg) {
                const int d = 32 * db + 8 * rg + 4 * hi;
                const u32x2 z_ = zz[db][rg];
                const float v0 = o[db][4 * rg + 0] * rl * bf_lo(z_.x), v1 = o[db][4 * rg + 1] * rl * bf_hi(z_.x);
                const float v2 = o[db][4 * rg + 2] * rl * bf_lo(z_.y), v3 = o[db][4 * rg + 3] * rl * bf_hi(z_.y);
                u32x2 w; w.x = cvtpk(v0, v1); w.y = cvtpk(v2, v3);
                *(u32x2*)(OB + rowoff + d) = w;
            }
        if (rb < 3) {
#pragma unroll
            for (int d0 = 0; d0 < 4; ++d0) qf[d0] = qn[d0];
        }
    }
}

__device__ __forceinline__ int permrow(int a) { const int r = a & 255; return (a & ~255) + ((r >> 5) & 1) * 128 + (r >> 6) * 32 + (r & 31); }
__device__ __forceinline__ void p0_transpose_item(const float* W, int K, int N, bf16_t* WT, LAS float* scr, int item, int lane, const float* kgain = nullptr, const float* kscale = nullptr) {
    const int nblk = N / 32, kb = item / nblk, nb = item - kb * nblk, k0 = 64 * kb, n0 = 32 * nb;
#pragma unroll 8
    for (int i = 0; i < 32; ++i) { const int kk = 2 * i + (lane >> 5); scr[kk * 33 + (lane & 31)] = W[(size_t)(k0 + kk) * N + n0 + (lane & 31)]; }
    LDS_WAIT();
    const int c = lane & 7;
    const int prow0 = permrow(n0);
#pragma unroll
    for (int jj = 0; jj < 4; ++jj) { const int n = (lane >> 3) + 8 * jj; const LAS float* s = scr + (8 * c) * 33 + n;
        f32x4 m0 = {1.f, 1.f, 1.f, 1.f}, m1 = {1.f, 1.f, 1.f, 1.f};
        if (kgain) { m0 = *(const f32x4*)(kgain + k0 + 8 * c) * (*(const f32x4*)(kscale + k0 + 8 * c) + 1.0f); m1 = *(const f32x4*)(kgain + k0 + 8 * c + 4) * (*(const f32x4*)(kscale + k0 + 8 * c + 4) + 1.0f); }
        u32x4 o; o.x = cvtpk(s[0 * 33] * m0[0], s[1 * 33] * m0[1]); o.y = cvtpk(s[2 * 33] * m0[2], s[3 * 33] * m0[3]); o.z = cvtpk(s[4 * 33] * m1[0], s[5 * 33] * m1[1]); o.w = cvtpk(s[6 * 33] * m1[2], s[7 * 33] * m1[3]);
        *(u32x4*)(WT + (size_t)(prow0 + n) * K + k0 + 8 * c) = o; }
    LDS_WAIT();
}
template <bool TWO, bool IN_BF16> __device__ __forceinline__ void norm_chunk(const void* Xv, int chunk, int lane,
        const float* g1, const float* sh1, const float* sc1, bf16_t* out1, const float* g2, const float* sh2, const float* sc2, bf16_t* out2, float* rstd_out = nullptr) {
    f32x4 A1[4], S1[4], A2[4], S2[4];
#pragma unroll
    for (int jj = 0; jj < 4; ++jj) { const int col = 4 * lane + 256 * jj;
        A1[jj] = *(const f32x4*)(g1 + col) * (*(const f32x4*)(sc1 + col) + 1.0f); S1[jj] = *(const f32x4*)(sh1 + col);
        if (TWO) { A2[jj] = *(const f32x4*)(g2 + col) * (*(const f32x4*)(sc2 + col) + 1.0f); S2[jj] = *(const f32x4*)(sh2 + col); } }
    for (int rr = 0; rr < 32; ++rr) {
        const size_t row = (size_t)chunk * 32 + rr;
        f32x4 v[4]; float ss = 0.f;
#pragma unroll
        for (int jj = 0; jj < 4; ++jj) {
            if (IN_BF16) { const u32x2 w = *(const u32x2*)((const bf16_t*)Xv + row * 1024 + 4 * lane + 256 * jj); v[jj] = (f32x4){bf_lo(w.x), bf_hi(w.x), bf_lo(w.y), bf_hi(w.y)}; }
            else v[jj] = *(const f32x4*)((const float*)Xv + row * 1024 + 4 * lane + 256 * jj);
            ss += (v[jj][0] * v[jj][0] + v[jj][1] * v[jj][1]) + (v[jj][2] * v[jj][2] + v[jj][3] * v[jj][3]); }
        const float rstd = rsqrtf(wave_sum(ss) * (1.0f / 1024.0f) + 1e-6f);
        if (rstd_out && lane == 0) rstd_out[row] = rstd;
#pragma unroll
        for (int jj = 0; jj < 4; ++jj) {
            const f32x4 xn = v[jj] * rstd;
            if (out1) { const f32x4 u = xn * A1[jj] + S1[jj]; u32x2 w; w.x = cvtpk(u[0], u[1]); w.y = cvtpk(u[2], u[3]); *(u32x2*)(out1 + row * 1024 + 4 * lane + 256 * jj) = w; }
            if (TWO) { const f32x4 u = xn * A2[jj] + S2[jj]; u32x2 w; w.x = cvtpk(u[0], u[1]); w.y = cvtpk(u[2], u[3]); *(u32x2*)(out2 + row * 1024 + 4 * lane + 256 * jj) = w; }
        }
    }
}

struct RowOrder {
    int nM, nN, G, c;
    __device__ void init(int M, int N, int G_, int c_) { nM = M / 256; nN = N / 256; G = G_; c = c_; }
    __device__ bool next(int i, pg8::Unit& u) const { const int pm = c + (i / nN) * G; if (pm >= nM) return false; u.pm = pm; u.pn = i % nN; return true; }
    __device__ __forceinline__ void a_ready(const pg8::Unit&) const {}
    __device__ __forceinline__ void done(const pg8::Unit&) const {}
};
struct Params { const float* in[26]; float* out; unsigned char* ws; int ph_lo, ph_hi; };

__global__ void __launch_bounds__(NTHREADS) yoco_fwd(Params P) {
    extern __shared__ __attribute__((aligned(16))) unsigned char lds_raw[];
    LAS unsigned char* lds = (LAS unsigned char*)lds_raw;
    const unsigned lds0 = (unsigned)(uintptr_t)lds_raw;
    LAS unsigned char* ring = lds + 16384; const unsigned ring0 = lds0 + 16384u;
    cg::grid_group grid = cg::this_grid();
    const int wave = __builtin_amdgcn_readfirstlane(threadIdx.x >> 6);
    const int G = gridDim.x, bx = blockIdx.x;
    const int vcu = (G % 8 == 0) ? (bx % 8) * (G / 8) + bx / 8 : bx;
    const int gw = vcu * 8 + wave, NGW = G * 8;
    unsigned char* ws = P.ws;
    const float* x = P.in[0];
    float* modA = (float*)(ws + WS_MOD); float* modKV = modA + 8 * 3072; float* modB = modKV + 8 * 2048;
    float* ctlf = (float*)(ws + WS_CTL);
    bf16_t* WinA = (bf16_t*)(ws + WS_WINA); bf16_t* WoutA = (bf16_t*)(ws + WS_WOUTA); bf16_t* Wkv = (bf16_t*)(ws + WS_WKV); bf16_t* WinB = (bf16_t*)(ws + WS_WINB); bf16_t* WoutB = (bf16_t*)(ws + WS_WOUTB);
    bf16_t* R0 = (bf16_t*)(ws + WS_R0); bf16_t* R1 = (bf16_t*)(ws + WS_R1); bf16_t* R2 = (bf16_t*)(ws + WS_R2); bf16_t* R3 = (bf16_t*)(ws + WS_R3); bf16_t* R4 = (bf16_t*)(ws + WS_R4);
    float* H = (float*)(ws + WS_H);
    const int lo = P.ph_lo, hi_ = P.ph_hi;
#ifndef REP_MASK
#define REP_MASK 0
#endif
#define NREP(k) ((((REP_MASK) >> (k)) & 1) + 1)
#ifndef PH_MASK
#define PH_MASK 0x1ff
#endif
#define IN(k) (((PH_MASK >> (k)) & 1) && lo <= (k) && (k) < hi_)
    unsigned* const xbar = (unsigned*)ctlf + 4096;
    const unsigned xcc_id = (unsigned)__builtin_amdgcn_s_getreg((3 << 11) | 20) & 0xFu;
    volatile LAS unsigned* const xst = (volatile LAS unsigned*)(lds + 8192);
#define GBAR() grid_bar(xbar, xcc_id, xst, wave)
#define SEAM(k) do { if (IN(k) && IN((k) + 1)) { if ((k) == 0) { grid.sync(); if (my_tid(wave) == 0) { xst[0] = 0u; xst[1] = 0u; (void)xb_add(&xbar[XB_XCNT(xcc_id)], 1u); } } else GBAR(); } } while (0)

    if (IN(0)) {
        const int tid = my_tid(wave), lane = tid & 63;
        LAS float* sc = (LAS float*)lds;
        LAS float* red = (LAS float*)(lds + 32768);
        const float* c = P.in[1];
        for (int i = tid; i < 8192; i += NTHREADS) { const int bb = i >> 10, k = i & 1023; const float v = c[i]; sc[k * 8 + bb] = v / (1.0f + __expf(-v)); }
        __syncthreads();
        for (int cgp = bx; cgp < 256; cgp += G) {
            const int n0 = cgp * 32;
            const float* W; const float* bias; int N, nloc; float* dst;
            if (n0 < 3072) { W = P.in[3]; bias = P.in[4]; N = 3072; nloc = n0; dst = modA; }
            else if (n0 < 5120) { W = P.in[15]; bias = P.in[16]; N = 2048; nloc = n0 - 3072; dst = modKV; }
            else { W = P.in[20]; bias = P.in[21]; N = 3072; nloc = n0 - 5120; dst = modB; }
            const int col = tid & 31, ks = tid >> 5;
            f32x4 a0 = {0.f, 0.f, 0.f, 0.f}, a1 = {0.f, 0.f, 0.f, 0.f};
#pragma unroll 8
            for (int kk = 0; kk < 64; ++kk) { const int k = ks * 64 + kk; const float w = W[(size_t)k * N + nloc + col];
                const f32x4 s0 = *(const LAS f32x4*)(sc + k * 8), s1 = *(const LAS f32x4*)(sc + k * 8 + 4); a0 += s0 * w; a1 += s1 * w; }
#pragma unroll
            for (int e = 0; e < 4; ++e) { red[(ks * 8 + e) * 32 + col] = a0[e]; red[(ks * 8 + 4 + e) * 32 + col] = a1[e]; }
            __syncthreads();
            if (tid < 256) { const int bb = tid >> 5, cc = tid & 31; float s = bias[nloc + cc];
#pragma unroll
                for (int k2 = 0; k2 < 16; ++k2) s += red[(k2 * 8 + bb) * 32 + cc];
                dst[(size_t)bb * N + nloc + cc] = s; }
            __syncthreads();
        }
        if (bx == 0 && wave == 0) {
            float a = P.in[8][lane] * P.in[9][lane], bq = P.in[10][lane] * P.in[11][lane];
            a = wave_sum(a); bq = wave_sum(bq);
            if (lane == 0) ctlf[0] = __expf(a) - __expf(bq) + 0.2f;
            const float gq = P.in[6][lane], gk = P.in[7][lane];
            ctlf[64 + lane] = gq; ctlf[128 + lane] = gk;
            float mq = fabsf(gq), mk = fabsf(gk);
#pragma unroll
            for (int o_ = 1; o_ < 64; o_ <<= 1) { mq = fmaxf(mq, __shfl_xor(mq, o_)); mk = fmaxf(mk, __shfl_xor(mk, o_)); }
            const float smax2 = pg8::QK_C2 * 64.0f * mq * mk * 1.02f;
            if (lane == 0) ctlf[1] = smax2;
            { float mqb = fabsf(P.in[23][lane]), mkb = fabsf(P.in[18][lane]);
#pragma unroll
              for (int o_ = 1; o_ < 64; o_ <<= 1) { mqb = fmaxf(mqb, __shfl_xor(mqb, o_)); mkb = fmaxf(mkb, __shfl_xor(mkb, o_)); }
              if (lane == 0) ctlf[2] = pg8::QK_C2 * 64.0f * mqb * mkb * 1.02f; }
            if (lane < 8) { const float sl2 = exp2f(-(float)(lane + 1)) * LOG2E; const float cf = (2.0f * smax2 + 160.0f) / sl2;
                const int ci = cf > 1.0e6f ? 1000000 : (int)cf + 1; ((int*)ctlf)[16 + lane] = ci; ((LAS int*)(lds + 131072))[lane] = ci;
                ((unsigned*)ctlf)[256 + 64 * lane] = 0u; ((unsigned*)ctlf)[256 + 512 + 64 * lane] = 0u; }
        }
        __syncthreads();
        if (bx == 0) { for (int i_ = tid; i_ < XCD_BAR_WORDS; i_ += NTHREADS) ((unsigned*)ctlf)[4096 + i_] = 0u; }
        if (bx == 0) {
            LAS int* cuts = (LAS int*)(lds + 131072); LAS int* wk = cuts + 64;
            { const int hh = tid >> 6, qq = tid & 63, dd = qq * 128 - cuts[hh]; wk[tid] = 2 * qq + 2 - (dd > 0 ? dd >> 6 : 0); }
            __syncthreads();
            { const int mine = wk[tid]; int rank = 0;
              for (int k2 = 0; k2 < 512; ++k2) { const int wo = wk[k2]; rank += (wo > mine || (wo == mine && k2 < tid)) ? 1 : 0; }
              ((int*)ctlf)[2048 + rank] = tid; }
        }
        __syncthreads();
        LAS float* scr = (LAS float*)(lds + wave * 16384);
        constexpr int I_A = 16 * 128, I_OA = 16 * 32, I_KV = 16 * 8, I_B = 16 * 64, I_OB = 16 * 32;
        for (int it = gw; it < I_A + I_OA + I_KV + I_B + I_OB; it += NGW) {
            int r = it;
            if (r < I_A) { p0_transpose_item(P.in[5], 1024, 4096, WinA, scr, r, lane); continue; } r -= I_A;
            if (r < I_OA) { p0_transpose_item(P.in[13], 1024, 1024, WoutA, scr, r, lane); continue; } r -= I_OA;
            if (r < I_KV) { p0_transpose_item(P.in[17], 1024, 256, Wkv, scr, r, lane); continue; } r -= I_KV;
            if (r < I_B) { p0_transpose_item(P.in[22], 1024, 2048, WinB, scr, r, lane); continue; } r -= I_B;
            p0_transpose_item(P.in[25], 1024, 1024, WoutB, scr, r, lane);
        }
    }
    SEAM(0);
    bf16_t* const WkvB = (bf16_t*)(ws + 20 * MiB);
    float* const rstdH = (float*)(ws + 24 * MiB);
    float* const ckv = ctlf + 8192;
    if (IN(1)) for (int rep = 0; rep < NREP(1); ++rep) {
        if (rep) GBAR();
        const int lane = my_tid(wave) & 63;
        {
            LAS float* scr2 = (LAS float*)(ring + wave * 16384);
            for (int it = gw; it < 8 * 128; it += NGW) { const int bb = it >> 7;
                p0_transpose_item(P.in[17], 1024, 256, WkvB + (size_t)bb * 256 * 1024, scr2, it & 127, lane, P.in[14], modKV + bb * 2048 + 1024); }
            for (int d_ = gw; d_ < 2048; d_ += NGW) { const int bb = d_ >> 8, a_ = d_ & 255;
                const bf16_t* wr_ = Wkv + (size_t)permrow(a_) * 1024 + 16 * lane; const float* sh_ = modKV + bb * 2048 + 16 * lane;
                const u32x4 w0 = *(const u32x4*)wr_, w1 = *(const u32x4*)(wr_ + 8); float acc_ = 0.f;
                acc_ += bf_lo(w0.x) * sh_[0] + bf_hi(w0.x) * sh_[1] + bf_lo(w0.y) * sh_[2] + bf_hi(w0.y) * sh_[3] + bf_lo(w0.z) * sh_[4] + bf_hi(w0.z) * sh_[5] + bf_lo(w0.w) * sh_[6] + bf_hi(w0.w) * sh_[7];
                acc_ += bf_lo(w1.x) * sh_[8] + bf_hi(w1.x) * sh_[9] + bf_lo(w1.y) * sh_[10] + bf_hi(w1.y) * sh_[11] + bf_lo(w1.z) * sh_[12] + bf_hi(w1.z) * sh_[13] + bf_lo(w1.w) * sh_[14] + bf_hi(w1.w) * sh_[15];
                acc_ = wave_sum(acc_); if (lane == 0) ckv[d_] = acc_; }
        }
        for (int chunk = gw; chunk < MROWS / 32; chunk += NGW) {
            const int bb = chunk >> 8;
            norm_chunk<false, false>(x, chunk, lane, P.in[2], modA + bb * 3072, modA + bb * 3072 + 1024, R0, nullptr, nullptr, nullptr, nullptr);
        }
    }
    SEAM(1);
    if (IN(2)) for (int rep = 0; rep < NREP(2); ++rep) {
        if (rep) GBAR();
        pg8::Gemm g{R0, WinA, MROWS, 4096, 1024}; pg8::StaticOrder S; S.init(MROWS, 4096, G, bx);
        pg8::EpiProj E{R1, (size_t)(64 * MiB), ctlf + 64, 16, 1024, 0x03201102};
        pg8::gemm_phase<pg8::EpiProj, pg8::StaticOrder, true, true>(ring, g, S, E, wave);
    }
    SEAM(2);
    if (IN(3)) for (int rep = 0; rep < NREP(3); ++rep) {
        if (rep) GBAR();
        const float lam = ctlf[0], smax2 = ctlf[1];
        const int* ctli = (const int*)ctlf; unsigned* qheads = (unsigned*)ctlf + 256 + 512 * rep;
        LAS int* misc = (LAS int*)lds;
        const int xcc = (int)(__builtin_amdgcn_s_getreg((3 << 11) | 20) & 7u);
        { const int t0_ = my_tid(wave); if (t0_ < 8) misc[8 + t0_] = ctli[16 + t0_]; misc[64 + t0_] = ctli[2048 + t0_];
          if (t0_ == 0) { int d_ = -1; for (int qi_ = 0; qi_ < 8; ++qi_) { const int bq_ = (xcc + qi_) & 7; const int ix_ = (int)atomicAdd(qheads + 64 * bq_, 1u); if (ix_ < 512) { d_ = (bq_ << 16) | ctli[2048 + ix_]; break; } } misc[1] = d_; } }
        __syncthreads();
        int cur = misc[1], par = 0, s0 = 0, pre = 0;
        bf16x8 qio[4];
#pragma unroll
        for (int k = 0; k < 4; ++k) qio[k] = (bf16x8){0, 0, 0, 0, 0, 0, 0, 0};
        while (cur >= 0) {
            const int bq = cur >> 16, h = (cur >> 6) & 7, qb = cur & 63, dd = qb * 128 - misc[8 + h];
            attnA_unit(wave, ring, ring0, s0, pre, misc + 1 + (par ^ 1), misc + 8, misc + 64, qheads, xcc, qio, bq, h, qb, dd > 0 ? dd >> 6 : 0, smax2, R1, R2, R3, R4, R0, P.in[12], lam);
            cur = misc[1 + (par ^ 1)];
            par ^= 1; s0 ^= 2; pre = 1;
        }
    }
    SEAM(3);
    if (IN(4)) for (int rep = 0; rep < NREP(4); ++rep) {
        if (rep) GBAR();
        pg8::Gemm g{R0, WoutA, MROWS, 1024, 1024}; RowOrder S; S.init(MROWS, 1024, G, bx);
        pg8::EpiRes<false, true> E{x, (void*)H, modA + 2048, 3072};
        pg8::gemm_phase<pg8::EpiRes<false, true>, RowOrder, true, true>(ring, g, S, E, wave);
    }
    if (IN(5)) {
        asm volatile("s_waitcnt vmcnt(0)" ::: "memory"); __threadfence_block(); __syncthreads();
        bf16_t* UKVb = (bf16_t*)(ws + WS_H + 128 * MiB);
        const int lane = my_tid(wave) & 63;
        for (int pm = bx; pm < MROWS / 256; pm += G) {
            const int chunk = pm * 8 + wave, bb = chunk >> 8;
            norm_chunk<true, true>(H, chunk, lane, P.in[14], modKV + bb * 2048, modKV + bb * 2048 + 1024, nullptr, P.in[19], modB + bb * 3072, modB + bb * 3072 + 1024, R1, rstdH);
        }
    }
    SEAM(5);
    if (IN(6)) for (int rep = 0; rep < NREP(6); ++rep) {
        if (rep) GBAR();
        { pg8::Gemm g{(const bf16_t*)H, WkvB, MROWS, 256, 1024, (size_t)256 * 1024}; pg8::StaticOrder S; S.init(MROWS, 256, G, bx);
          pg8::EpiProjT<true> E{R4, (size_t)128, P.in[18], 2, 256, 0x00000001, rstdH, ckv, 256};
          pg8::gemm_phase<pg8::EpiProjT<true>, pg8::StaticOrder, true, true>(ring, g, S, E, wave); }
        { pg8::Gemm g{R1, WinB, MROWS, 2048, 1024}; pg8::StaticOrder S; S.init(MROWS, 2048, G, bx);
          pg8::EpiProj E{R2, (size_t)(64 * MiB), P.in[23], 16, 1024, 0x00000302};
          pg8::gemm_phase<pg8::EpiProj, pg8::StaticOrder, true, true>(ring, g, S, E, wave); }
    }
    SEAM(6);
    if (IN(7)) for (int rep = 0; rep < NREP(7); ++rep) {
        if (rep) GBAR();
        {
            const float smax2B = ctlf[2];
            const int lane_ = my_tid(wave) & 63;
            int u = vcu, par = 0;
            if (u < 1024) attnB_stage(wave, lane_, ring0, u >> 7, (u >> 6) & 1, u & 63, R4);
            for (; u < 1024; u += G, par ^= 1) {
                WAIT_BAR(0);
                if (u + G < 1024) { const int u2 = u + G; attnB_stage(wave, my_tid(wave) & 63, ring0 + (par ^ 1) * 65536u, u2 >> 7, (u2 >> 6) & 1, u2 & 63, R4); }
                attnB_unit(wave, ring + par * 65536, u >> 7, (u >> 6) & 1, u & 63, smax2B, R2, R3, R1, P.in[24]);
            }
            WAIT_BAR(0);
        }
    }
    SEAM(7);
    if (IN(8)) {
        pg8::Gemm g{R1, WoutB, MROWS, 1024, 1024}; pg8::StaticOrder S; S.init(MROWS, 1024, G, bx);
        pg8::EpiRes<true, false> E{H, P.out, modB + 2048, 3072};
        pg8::gemm_phase<pg8::EpiRes<true, false>, pg8::StaticOrder, true, true>(ring, g, S, E, wave);
    }
#undef IN
#undef SEAM
}

extern "C" void kernel_launch(void* const* d_in, const int* in_sizes, int n_in, void* d_out, int out_size, void* d_ws, size_t ws_size, hipStream_t stream) {
    static int grid = 0;
    if (grid == 0) {
        if (n_in != 26 || out_size != MROWS * DM || ws_size < WS_END) { fprintf(stderr, "kernel_launch: unexpected shapes (n_in %d out %d ws %zu)\n", n_in, out_size, ws_size); grid = -1; return; }
        int dev = 0, cus = 0, per_cu = 0;
        hipGetDevice(&dev); hipDeviceGetAttribute(&cus, hipDeviceAttributeMultiprocessorCount, dev);
        hipFuncSetAttribute((const void*)yoco_fwd, hipFuncAttributeMaxDynamicSharedMemorySize, LDS_BYTES);
        if (hipOccupancyMaxActiveBlocksPerMultiprocessor(&per_cu, (const void*)yoco_fwd, NTHREADS, LDS_BYTES) != hipSuccess || per_cu < 1) { fprintf(stderr, "kernel_launch: occupancy query gave %d\n", per_cu); per_cu = 1; }
        (void)hipGetLastError();
        grid = cus * per_cu;
    }
    if (grid < 0) return;
    Params p{};
    for (int i = 0; i < 26; ++i) p.in[i] = (const float*)d_in[i];
    p.out = (float*)d_out; p.ws = (unsigned char*)d_ws; p.ph_lo = 0; p.ph_hi = 9;
    void* args[] = {&p};
    hipError_t e = hipLaunchCooperativeKernel((const void*)yoco_fwd, dim3(grid), dim3(NTHREADS), args, LDS_BYTES, stream);
    if (e != hipSuccess) fprintf(stderr, "cooperative launch failed: %s (grid %d)\n", hipGetErrorString(e), grid);
}
```

```cpp
#include <hip/hip_runtime.h>
#include <hip/hip_cooperative_groups.h>
#include <cstdio>
#include <cstdint>
namespace cg = cooperative_groups;
namespace pg8 {
#define PG8_LAS __attribute__((address_space(3)))
typedef unsigned short bf16_t;
typedef short bf16x8 __attribute__((ext_vector_type(8)));
typedef float f32x4 __attribute__((ext_vector_type(4)));
typedef unsigned u32x4 __attribute__((ext_vector_type(4)));
constexpr int BM = 256, BK = 64, HALF = 128, HTB = HALF * BK * 2  , STAGE_BYTES = 8 * HTB, NXCD = 8, WGM = 8;

__host__ __device__ __forceinline__ int lds_byte(int r, int c) { const int st = (r >> 4) * 2 + (c >> 5), rr = r & 15, cc = c & 31, ob = rr * 64 + cc * 2; return st * 1024 + (ob ^ (((ob >> 9) & 1) << 5)); }
__host__ __device__ __forceinline__ void stage_rc(int b, int& R, int& C) { const int st = b / 1024, sb = b % 1024, swz = sb ^ (((sb >> 9) & 1) << 5); R = (st >> 1) * 16 + swz / 64; C = (st & 1) * 32 + (swz % 64) / 2; }
__host__ __device__ __forceinline__ int perm32(int rho) { const int n = rho >> 4, i = rho & 15; return 8 * (i >> 2) + 4 * n + (i & 3); }

struct Unit { int pm, pn; };
struct Gemm { const bf16_t* A; const bf16_t* Bt; int M, N, K; size_t bstride = 0; };

struct StaticOrder {
    int nM, nN, nwg, G, c;
    __host__ __device__ void init(int M, int N, int G_, int c_) { nM = M / BM; nN = N / BM; nwg = nM * nN; G = G_; c = c_; }
    __host__ __device__ bool next(int i, Unit& u) const {
        const long L = (long)i * G + c; if (L >= nwg) return false;
        int wgid = (int)L; { const int q = nwg / NXCD, r = nwg % NXCD, xcd = wgid % NXCD, off = wgid / NXCD; wgid = (xcd < r ? xcd * (q + 1) : r * (q + 1) + (xcd - r) * q) + off; }
        const int nig = WGM * nN, gid = wgid / nig, fm = gid * WGM, gsz = (nM - fm) < WGM ? (nM - fm) : WGM;
        u.pm = fm + ((wgid % nig) % gsz); u.pn = (wgid % nig) / gsz; return true;
    }
    __device__ __forceinline__ void a_ready(const Unit&) const {}
    __device__ __forceinline__ void done(const Unit&) const {}
};

__device__ __forceinline__ unsigned cvt_pk_bf16(float lo, float hi) { unsigned r; asm volatile("v_cvt_pk_bf16_f32 %0, %1, %2" : "=v"(r) : "v"(lo), "v"(hi)); return r; }
typedef unsigned u32x4e __attribute__((ext_vector_type(4)));
constexpr float QK_C2 = 0.125f * 1.4426950408889634f;
template <bool AFF> struct EpiProjT {
    static constexpr bool PERM = true, AFTER_DRAIN = false;
    bf16_t* out0; size_t tstride;
    const float* gtab;
    int hpt, ldo;
    int modes;
    const float* rstd = nullptr; const float* cbias = nullptr; int cb_ld = 0;
    __device__ __forceinline__ void operator()(const f32x4 (&acc)[2][2][4][2], const Unit& u, int wr, int wc, int fr, int fq) const {
        const int head = u.pn * 4 + wc, ty = head / hpt, hh = head - ty * hpt;
        bf16_t* base = out0 + (size_t)ty * tstride;
        const int mode = (modes >> (8 * ty)) & 15, lay = (modes >> (8 * ty + 4)) & 15;
        const float* g = gtab + 64 * ty;
        int row0 = u.pm * BM + wr * 64 + fr, colh = hh * 64 + 8 * fq, ldo = this->ldo;
        const int trow0 = row0;
        f32x4 cbv[2][2];
#pragma unroll
        for (int bj = 0; bj < 2; ++bj)
#pragma unroll
            for (int n = 0; n < 2; ++n) cbv[bj][n] = AFF ? *(const f32x4*)(cbias + (size_t)(u.pm >> 5) * cb_ld + head * 64 + 32 * bj + 8 * fq + 4 * n) : (f32x4){0.f, 0.f, 0.f, 0.f};
        if (lay == 1) { const int bb = row0 >> 13; row0 = (bb * hpt + hh) * 8192 + (row0 & 8191); colh = 8 * fq; ldo = 64; }
        else if (lay == 2) { const int bb = row0 >> 13; row0 = (bb * (hpt >> 1) + (hh >> 1)) * 8192 + (row0 & 8191); colh = (hh & 1) * 64 + 8 * fq; ldo = 128; }
        if (mode == 1 || mode == 2) {
            const float gs = mode == 2 ? QK_C2 : 1.0f;
            f32x4 gv[2][2];
#pragma unroll
            for (int bj = 0; bj < 2; ++bj)
#pragma unroll
                for (int n = 0; n < 2; ++n) gv[bj][n] = *(const f32x4*)(g + 32 * bj + 8 * fq + 4 * n) * gs;
#pragma unroll
            for (int ai = 0; ai < 2; ++ai)
#pragma unroll
                for (int m = 0; m < 4; ++m) {
                    const float rs_ = AFF ? rstd[trow0 + ai * HALF + m * 16] : 1.0f;
                    f32x4 xv[2][2];
                    float ss = 0.f;
#pragma unroll
                    for (int bj = 0; bj < 2; ++bj)
#pragma unroll
                        for (int n = 0; n < 2; ++n) { const f32x4 x = AFF ? acc[ai][bj][m][n] * rs_ + cbv[bj][n] : acc[ai][bj][m][n]; xv[bj][n] = x; ss += (x[0] * x[0] + x[1] * x[1]) + (x[2] * x[2] + x[3] * x[3]); }
                    { auto r16 = __builtin_amdgcn_permlane16_swap(__float_as_uint(ss), __float_as_uint(ss), false, false); ss = __uint_as_float(r16[0]) + __uint_as_float(r16[1]);
                      auto r32 = __builtin_amdgcn_permlane32_swap(__float_as_uint(ss), __float_as_uint(ss), false, false); ss = __uint_as_float(r32[0]) + __uint_as_float(r32[1]); }
                    const float rstd_h = rsqrtf(ss * (1.0f / 64.0f) + 1e-6f);
                    bf16_t* rowp = base + (size_t)(row0 + ai * HALF + m * 16) * ldo + colh;
#pragma unroll
                    for (int bj = 0; bj < 2; ++bj) { const f32x4 v0 = xv[bj][0] * rstd_h * gv[bj][0], v1 = xv[bj][1] * rstd_h * gv[bj][1];
                        u32x4e w; w.x = cvt_pk_bf16(v0[0], v0[1]); w.y = cvt_pk_bf16(v0[2], v0[3]); w.z = cvt_pk_bf16(v1[0], v1[1]); w.w = cvt_pk_bf16(v1[2], v1[3]);
                        *(u32x4e*)(rowp + bj * 32) = w; }
                }
        } else {
#pragma unroll
            for (int ai = 0; ai < 2; ++ai)
#pragma unroll
                for (int m = 0; m < 4; ++m) {
                    bf16_t* rowp = base + (size_t)(row0 + ai * HALF + m * 16) * ldo + colh;
                    const float rs_ = AFF ? rstd[trow0 + ai * HALF + m * 16] : 1.0f;
#pragma unroll
                    for (int bj = 0; bj < 2; ++bj) { f32x4 v0 = acc[ai][bj][m][0], v1 = acc[ai][bj][m][1]; if (AFF) { v0 = v0 * rs_ + cbv[bj][0]; v1 = v1 * rs_ + cbv[bj][1]; }
                        if (mode == 3) {
#pragma unroll
                            for (int e = 0; e < 4; ++e) { v0[e] = v0[e] * __builtin_amdgcn_rcpf(1.0f + __expf(-v0[e])); v1[e] = v1[e] * __builtin_amdgcn_rcpf(1.0f + __expf(-v1[e])); } }
                        u32x4e w; w.x = cvt_pk_bf16(v0[0], v0[1]); w.y = cvt_pk_bf16(v0[2], v0[3]); w.z = cvt_pk_bf16(v1[0], v1[1]); w.w = cvt_pk_bf16(v1[2], v1[3]);
                        *(u32x4e*)(rowp + bj * 32) = w; }
                }
        }
    }
};
typedef EpiProjT<false> EpiProj;
template <bool BASE_BF16, bool OUT_BF16> struct EpiRes {
    static constexpr bool PERM = true, AFTER_DRAIN = false;
    const void* base; void* out; const float* gate; int ldg;
    __device__ __forceinline__ void operator()(const f32x4 (&acc)[2][2][4][2], const Unit& u, int wr, int wc, int fr, int fq) const {
        const int col = (u.pn * 4 + wc) * 64 + 8 * fq, row0 = u.pm * BM + wr * 64 + fr;
        const float* gp = gate + (size_t)(u.pm >> 5) * ldg + col;
        f32x4 gv[2][2];
#pragma unroll
        for (int bj = 0; bj < 2; ++bj)
#pragma unroll
            for (int n = 0; n < 2; ++n) gv[bj][n] = *(const f32x4*)(gp + 32 * bj + 4 * n);
#pragma unroll
        for (int ai = 0; ai < 2; ++ai) {
            f32x4 bs[4][2][2];
#pragma unroll
            for (int m = 0; m < 4; ++m) { const size_t off = (size_t)(row0 + ai * HALF + m * 16) * 1024 + col;
#pragma unroll
                for (int bj = 0; bj < 2; ++bj) {
                    if (BASE_BF16) { const u32x4e w = *(const u32x4e*)((const bf16_t*)base + off + 32 * bj);
                        bs[m][bj][0] = (f32x4){__uint_as_float(w.x << 16), __uint_as_float(w.x & 0xffff0000u), __uint_as_float(w.y << 16), __uint_as_float(w.y & 0xffff0000u)};
                        bs[m][bj][1] = (f32x4){__uint_as_float(w.z << 16), __uint_as_float(w.z & 0xffff0000u), __uint_as_float(w.w << 16), __uint_as_float(w.w & 0xffff0000u)}; }
                    else { bs[m][bj][0] = *(const f32x4*)((const float*)base + off + 32 * bj); bs[m][bj][1] = *(const f32x4*)((const float*)base + off + 32 * bj + 4); } } }
            asm volatile("" ::: "memory");
#pragma unroll
            for (int m = 0; m < 4; ++m) { const size_t off = (size_t)(row0 + ai * HALF + m * 16) * 1024 + col;
#pragma unroll
                for (int bj = 0; bj < 2; ++bj) { const f32x4 v0 = bs[m][bj][0] + gv[bj][0] * acc[ai][bj][m][0], v1 = bs[m][bj][1] + gv[bj][1] * acc[ai][bj][m][1];
                    if (OUT_BF16) { u32x4e w; w.x = cvt_pk_bf16(v0[0], v0[1]); w.y = cvt_pk_bf16(v0[2], v0[3]); w.z = cvt_pk_bf16(v1[0], v1[1]); w.w = cvt_pk_bf16(v1[2], v1[3]); *(u32x4e*)((bf16_t*)out + off + 32 * bj) = w; }
                    else { *(f32x4*)((float*)out + off + 32 * bj) = v0; *(f32x4*)((float*)out + off + 32 * bj + 4) = v1; } } }
            asm volatile("" ::: "memory");
        }
    }
};
template <class Epi, class Sched, bool ALIGN_EPI = false, bool SP2 = false>
__device__ __forceinline__ void gemm_phase(PG8_LAS unsigned char* lds, const Gemm g, const Sched& S, const Epi& E, const int wave_) {
    int tid; { int l_; asm volatile("v_mbcnt_lo_u32_b32 %0, -1, 0\n\tv_mbcnt_hi_u32_b32 %0, -1, %0" : "=v"(l_)); tid = wave_ * 64 + l_; }
    const int wid = __builtin_amdgcn_readfirstlane(tid >> 6), lane = tid & 63, wr = wid >> 2, wc = wid & 3, fr = lane & 15, fq = lane >> 4;
    const int K = g.K, nt = K / BK;
    unsigned voffA[2], voffB[2];
#pragma unroll
    for (int i = 0; i < 2; ++i) { int R, C; stage_rc(tid * 16 + i * 8192, R, C); const int Rb = Epi::PERM ? ((R & ~31) + perm32(R & 31)) : R;
        voffA[i] = (unsigned)(R * K + C) * 2u; voffB[i] = (unsigned)(Rb * K + C) * 2u; }
    const size_t kstep = (size_t)(BK * 2);
    const size_t hstep = (size_t)HALF * K * 2;
    const size_t tstep = 2 * hstep;
    const unsigned ldsw = (unsigned)wid * 1024u;
    const int aoff = lds_byte(wr * 64 + fr, fq * 8), boff = lds_byte(wc * 32 + fr, fq * 8);
#define PG8_SA(b, h) (((b) * 2 + (h)) * HTB)
#define PG8_SB(b, h) ((4 + (b) * 2 + (h)) * HTB)
#define PG8_STAGE(bufoff, gbase, voff) do { _Pragma("unroll") for (int _i = 0; _i < 2; ++_i) \
        __builtin_amdgcn_global_load_lds((const unsigned*)((const char*)(gbase) + (voff)[_i]), (PG8_LAS unsigned*)(lds + (bufoff) + ldsw + _i * 8192), 16, 0, 0); } while (0)
#define PG8_LDA(dst, b, h) do { _Pragma("unroll") for (int m = 0; m < 4; ++m) _Pragma("unroll") for (int k = 0; k < 2; ++k) dst[m][k] = *(const PG8_LAS bf16x8*)(lds + PG8_SA(b, h) + aoff + m * 2048 + k * 1024); } while (0)
#define PG8_LDB(dst, b, h) do { _Pragma("unroll") for (int n = 0; n < 2; ++n) _Pragma("unroll") for (int k = 0; k < 2; ++k) dst[n][k] = *(const PG8_LAS bf16x8*)(lds + PG8_SB(b, h) + boff + n * 2048 + k * 1024); } while (0)
#define PG8_MMA(ai, bj, At, Bt) do { __builtin_amdgcn_s_setprio(1); _Pragma("unroll") for (int m = 0; m < 4; ++m) _Pragma("unroll") for (int n = 0; n < 2; ++n) _Pragma("unroll") for (int k = 0; k < 2; ++k) \
        acc[ai][bj][m][n] = __builtin_amdgcn_mfma_f32_16x16x32_bf16(Bt[n][k], At[m][k], acc[ai][bj][m][n], 0, 0, 0); __builtin_amdgcn_s_setprio(0); } while (0)
#define PG8_WAIT_V(n) asm volatile("s_waitcnt vmcnt(" #n ")" ::: "memory")
#define PG8_WAIT_L(n) asm volatile("s_waitcnt lgkmcnt(" #n ")" ::: "memory")
#define PG8_BAR __builtin_amdgcn_s_barrier()
#define PG8_SCHED __builtin_amdgcn_sched_barrier(0)
    Unit cur, nxt; int ui = 0;
    if (!S.next(0, cur)) return;
    f32x4 acc[2][2][4][2];
#pragma unroll
    for (int a = 0; a < 2; ++a)
#pragma unroll
        for (int b = 0; b < 2; ++b)
#pragma unroll
            for (int m = 0; m < 4; ++m)
#pragma unroll
                for (int n = 0; n < 2; ++n) acc[a][b][m][n] = (f32x4){0.f, 0.f, 0.f, 0.f};
    bf16x8 At[4][2], B0[2][2], B1[2][2];
    const char* cA = (const char*)g.A + (size_t)cur.pm * tstep; const char* cB = (const char*)g.Bt + (size_t)cur.pn * tstep + (size_t)(cur.pm >> 5) * g.bstride * 2;
    S.a_ready(cur);
    if constexpr (SP2) {
        PG8_STAGE(PG8_SB(0, 0), cB, voffB); PG8_STAGE(PG8_SB(0, 1), cB + hstep, voffB); PG8_STAGE(PG8_SA(0, 0), cA, voffA); PG8_STAGE(PG8_SA(0, 1), cA + hstep, voffA);
        if (wr == 1) PG8_BAR;
        PG8_WAIT_V(2); PG8_BAR;
        PG8_STAGE(PG8_SB(1, 0), cB + kstep, voffB); PG8_STAGE(PG8_SA(1, 0), cA + kstep, voffA); PG8_STAGE(PG8_SB(1, 1), cB + hstep + kstep, voffB);
        PG8_WAIT_V(6); PG8_BAR;
    } else {
        PG8_STAGE(PG8_SB(0, 0), cB, voffB); PG8_STAGE(PG8_SA(0, 0), cA, voffA); PG8_STAGE(PG8_SB(0, 1), cB + hstep, voffB); PG8_STAGE(PG8_SA(0, 1), cA + hstep, voffA);
        if (wr == 1) PG8_BAR;
        PG8_WAIT_V(4); PG8_BAR;
        PG8_STAGE(PG8_SB(1, 0), cB + kstep, voffB); PG8_STAGE(PG8_SA(1, 0), cA + kstep, voffA); PG8_STAGE(PG8_SB(1, 1), cB + hstep + kstep, voffB);
        PG8_WAIT_V(6); PG8_BAR;
    }
    for (;;) {
        const bool has_next = S.next(ui + 1, nxt);
        const char* nA = has_next ? (const char*)g.A + (size_t)nxt.pm * tstep : cA; const char* nB = has_next ? (const char*)g.Bt + (size_t)nxt.pn * tstep + (size_t)(nxt.pm >> 5) * g.bstride * 2 : cB;
        for (int t = 0; t < nt; t += 2) {
            const bool last = (t == nt - 2);
            const char* a1 = cA + (size_t)(t + 1) * kstep;
            const char* a2 = last ? nA : cA + (size_t)(t + 2) * kstep; const char* b2 = last ? nB : cB + (size_t)(t + 2) * kstep;
            const char* a3 = a2 + kstep; const char* b3 = b2 + kstep;
            if (last && has_next) S.a_ready(nxt);
            if constexpr (SP2) {
            PG8_LDB(B0, 0, 0); PG8_LDB(B1, 0, 1); PG8_SCHED; PG8_LDA(At, 0, 0); PG8_STAGE(PG8_SA(1, 1), a1 + hstep, voffA);
            PG8_WAIT_V(8); PG8_WAIT_L(0); PG8_BAR; PG8_MMA(0, 0, At, B0); PG8_MMA(0, 1, At, B1); PG8_BAR; PG8_SCHED;
            PG8_LDA(At, 0, 1); PG8_STAGE(PG8_SB(0, 0), b2, voffB); PG8_STAGE(PG8_SB(0, 1), b2 + hstep, voffB); PG8_STAGE(PG8_SA(0, 0), a2, voffA);
            PG8_WAIT_V(8); PG8_WAIT_L(0); PG8_BAR; PG8_MMA(1, 0, At, B0); PG8_MMA(1, 1, At, B1); PG8_BAR; PG8_SCHED;
            PG8_LDB(B0, 1, 0); PG8_LDB(B1, 1, 1); PG8_SCHED; PG8_LDA(At, 1, 0); PG8_STAGE(PG8_SA(0, 1), a2 + hstep, voffA);
            PG8_WAIT_V(8); PG8_WAIT_L(0); PG8_BAR; PG8_MMA(0, 0, At, B0); PG8_MMA(0, 1, At, B1); PG8_BAR; PG8_SCHED;
            PG8_LDA(At, 1, 1); PG8_STAGE(PG8_SB(1, 0), b3, voffB); PG8_STAGE(PG8_SB(1, 1), b3 + hstep, voffB); PG8_STAGE(PG8_SA(1, 0), a3, voffA);
            PG8_WAIT_V(8); PG8_WAIT_L(0); PG8_BAR; PG8_MMA(1, 0, At, B0); PG8_MMA(1, 1, At, B1); PG8_BAR; PG8_SCHED;
            } else {
            PG8_LDB(B0, 0, 0); PG8_SCHED; PG8_LDA(At, 0, 0); PG8_STAGE(PG8_SA(1, 1), a1 + hstep, voffA);
            PG8_WAIT_L(8); PG8_BAR; PG8_WAIT_L(0); PG8_MMA(0, 0, At, B0); PG8_BAR; PG8_SCHED;
            PG8_LDB(B1, 0, 1); PG8_STAGE(PG8_SB(0, 0), b2, voffB);
            PG8_BAR; PG8_WAIT_L(0); PG8_MMA(0, 1, At, B1); PG8_BAR;
            PG8_LDA(At, 0, 1); PG8_STAGE(PG8_SA(0, 0), a2, voffA);
            PG8_BAR; PG8_WAIT_L(0); PG8_MMA(1, 0, At, B0); PG8_BAR; PG8_SCHED;
            PG8_STAGE(PG8_SB(0, 1), b2 + hstep, voffB);
            PG8_WAIT_V(6); PG8_BAR; PG8_MMA(1, 1, At, B1); PG8_BAR;
            PG8_LDB(B0, 1, 0); PG8_SCHED; PG8_LDA(At, 1, 0); PG8_STAGE(PG8_SA(0, 1), a2 + hstep, voffA);
            PG8_WAIT_L(8); PG8_BAR; PG8_WAIT_L(0); PG8_MMA(0, 0, At, B0); PG8_BAR; PG8_SCHED;
            PG8_LDB(B1, 1, 1); PG8_STAGE(PG8_SB(1, 0), b3, voffB);
            PG8_BAR; PG8_WAIT_L(0); PG8_MMA(0, 1, At, B1); PG8_BAR;
            PG8_LDA(At, 1, 1); PG8_STAGE(PG8_SA(1, 0), a3, voffA);
            PG8_BAR; PG8_WAIT_L(0); PG8_MMA(1, 0, At, B0); PG8_BAR; PG8_SCHED;
            PG8_STAGE(PG8_SB(1, 1), b3 + hstep, voffB);
            PG8_WAIT_V(6); PG8_BAR; PG8_MMA(1, 1, At, B1); PG8_BAR;
            }
        }
        if constexpr (ALIGN_EPI) { if (wr == 0) PG8_BAR; }
        if constexpr (!Epi::AFTER_DRAIN) { E(acc, cur, wr, wc, fr, fq); S.done(cur); }
        if (!has_next) break;
#pragma unroll
        for (int a = 0; a < 2; ++a)
#pragma unroll
            for (int b = 0; b < 2; ++b)
#pragma unroll
                for (int m = 0; m < 4; ++m)
#pragma unroll
                    for (int n = 0; n < 2; ++n) acc[a][b][m][n] = (f32x4){0.f, 0.f, 0.f, 0.f};
        cur = nxt; cA = nA; cB = nB; ++ui;
        if constexpr (ALIGN_EPI) { if (wr == 1) PG8_BAR; }
    }
    PG8_WAIT_V(0);
    if constexpr (!ALIGN_EPI) { if (wr == 0) PG8_BAR; }
    PG8_BAR;
    if constexpr (Epi::AFTER_DRAIN) { E.fused(acc, cur, wr, wc, fr, fq, lds, wid, lane); S.done(cur); }
#undef PG8_SA
#undef PG8_SB
#undef PG8_STAGE
#undef PG8_LDA
#undef PG8_LDB
#undef PG8_MMA
#undef PG8_WAIT_V
#undef PG8_WAIT_L
#undef PG8_BAR
#undef PG8_SCHED
}
}
constexpr int BATCH = 8, SEQ = 8192, DM = 1024, MROWS = BATCH * SEQ;
constexpr float LOG2E = 1.4426950408889634f;
constexpr size_t MiB = 1u << 20;
constexpr size_t WS_CTL = 0, WS_MOD = 1 * MiB, WS_WINA = 2 * MiB, WS_WOUTA = 10 * MiB, WS_WKV = 12 * MiB, WS_WINB = 13 * MiB, WS_WOUTB = 17 * MiB;
constexpr size_t WS_R0 = 32 * MiB, WS_R1 = 160 * MiB, WS_R2 = 288 * MiB, WS_R3 = 416 * MiB, WS_R4 = 544 * MiB, WS_H = 672 * MiB, WS_END = 928 * MiB;
constexpr int LDS_BYTES = 147456;
constexpr int NTHREADS = 512;

#define LAS __attribute__((address_space(3)))
typedef unsigned short bf16_t;
typedef short bf16x8 __attribute__((ext_vector_type(8)));
typedef short s16x4 __attribute__((ext_vector_type(4)));
typedef float f32x4 __attribute__((ext_vector_type(4)));
typedef float f32x16 __attribute__((ext_vector_type(16)));
typedef unsigned u32x4 __attribute__((ext_vector_type(4)));
typedef unsigned u32x2 __attribute__((ext_vector_type(2)));
typedef LAS const unsigned char* lds_cptr;

__device__ __forceinline__ unsigned cvtpk(float lo, float hi) { unsigned r; asm("v_cvt_pk_bf16_f32 %0, %1, %2" : "=v"(r) : "v"(lo), "v"(hi)); return r; }
__device__ __forceinline__ float bf_lo(unsigned w) { return __uint_as_float(w << 16); }
__device__ __forceinline__ float bf_hi(unsigned w) { return __uint_as_float(w & 0xffff0000u); }
__device__ __forceinline__ float wave_sum(float v) {
#pragma unroll
    for (int o = 1; o < 64; o <<= 1) v += __shfl_xor(v, o);
    return v;
}
__device__ __forceinline__ float half_swap_max(float m) { auto rr = __builtin_amdgcn_permlane32_swap(__float_as_uint(m), __float_as_uint(m), false, false); return fmaxf(__uint_as_float(rr[0]), __uint_as_float(rr[1])); }
__device__ __forceinline__ float half_swap_sum(float m) { auto rr = __builtin_amdgcn_permlane32_swap(__float_as_uint(m), __float_as_uint(m), false, false); return __uint_as_float(rr[0]) + __uint_as_float(rr[1]); }
__device__ __forceinline__ int my_tid(int wave) { int l_; asm volatile("v_mbcnt_lo_u32_b32 %0, -1, 0\n\tv_mbcnt_hi_u32_b32 %0, -1, %0" : "=v"(l_)); return wave * 64 + l_; }
#define XB_TMO      128
#define XB_XCNT(j)  (256  + 64 * (j))
#define XB_XSUB(j)  (1280 + 64 * (j))
#define XB_XGEN(j)  (2304 + 64 * (j))
#define XB_TOP      3328
#define XB_TOPGEN   3392
#define XCD_BAR_WORDS 3456
#define XB_SPIN_CAP (1u << 23)
__device__ __forceinline__ unsigned xb_ld(unsigned* p)              { return __hip_atomic_load(p, __ATOMIC_RELAXED, __HIP_MEMORY_SCOPE_AGENT); }
__device__ __forceinline__ unsigned xb_add(unsigned* p, unsigned v) { return __hip_atomic_fetch_add(p, v, __ATOMIC_RELAXED, __HIP_MEMORY_SCOPE_AGENT); }
#define XB_SPIN(cond, bar) do { unsigned _sp = 0; while (cond) { __builtin_amdgcn_s_sleep(1); \
    if ((++_sp & 255u) == 0u) { if (xb_ld(&(bar)[XB_TMO])) break; if (_sp > XB_SPIN_CAP) { atomicAdd(&(bar)[XB_TMO], 1u); break; } } } } while (0)
__device__ __forceinline__ void grid_bar(unsigned* bar, const unsigned x, volatile LAS unsigned* st, int wave) {
    asm volatile("s_waitcnt vmcnt(0)" ::: "memory");
    __syncthreads();
    if (my_tid(wave) == 0) {
        __builtin_amdgcn_s_waitcnt(0);
        unsigned nloc = st[0], nx = st[1];
        if (nloc == 0u) {
            const unsigned G_ = gridDim.x; unsigned sum, cnt, mine, sp = 0u;
            for (;;) {
                sum = 0u; cnt = 0u; mine = 0u;
#pragma unroll
                for (unsigned jx = 0; jx < 16; ++jx) { const unsigned c_ = xb_ld(&bar[XB_XCNT(jx)]); sum += c_; cnt += (c_ > 0u) ? 1u : 0u; mine = (jx == x) ? c_ : mine; }
                if (sum == G_) break;
                __builtin_amdgcn_s_sleep(1);
                if ((++sp & 255u) == 0u) { if (xb_ld(&bar[XB_TMO])) break; if (sp > XB_SPIN_CAP) { atomicAdd(&bar[XB_TMO], 1u); break; } }
            }
            nloc = mine > 0u ? mine : 1u; nx = cnt > 0u ? cnt : 1u; st[0] = nloc; st[1] = nx;
        }
        const unsigned old = xb_add(&bar[XB_XSUB(x)], 1u);
        const unsigned gen = old / nloc;
        if (old + 1u == (gen + 1u) * nloc) {
            __builtin_amdgcn_fence(__ATOMIC_RELEASE, "agent");
            asm volatile("s_waitcnt vmcnt(0)" ::: "memory");
            const unsigned og = xb_add(&bar[XB_TOP], 1u);
            const unsigned tg = og / nx;
            if (og + 1u == (tg + 1u) * nx) xb_add(&bar[XB_TOPGEN], 1u);
            else XB_SPIN(xb_ld(&bar[XB_TOPGEN]) == tg, bar);
            __builtin_amdgcn_fence(__ATOMIC_ACQUIRE, "agent");
            xb_add(&bar[XB_XGEN(x)], 1u);
            asm volatile("s_waitcnt vmcnt(0)" ::: "memory");
        } else {
            XB_SPIN(xb_ld(&bar[XB_XGEN(x)]) == gen, bar);
            __builtin_amdgcn_fence(__ATOMIC_ACQUIRE, "agent");
            asm volatile("s_waitcnt vmcnt(0)" ::: "memory");
        }
    }
    __syncthreads();
}
__device__ __forceinline__ int crow(int r, int hi) { return (r & 3) + 8 * (r >> 2) + 4 * hi; }
__device__ __forceinline__ void glds16(const void* g, unsigned lds_base) {
    unsigned sv; asm volatile("s_mov_b32 %0, m0\n\ts_mov_b32 m0, %2\n\ts_nop 0\n\tglobal_load_lds_dwordx4 %1, off\n\ts_mov_b32 m0, %0" : "=&s"(sv) : "v"(g), "s"(lds_base) : "memory"); }
#define GLDS(g, dst) glds16((g), (unsigned)__builtin_amdgcn_readfirstlane((int)(dst)))
#define WAIT_BAR(N) asm volatile("s_waitcnt vmcnt(" #N ") lgkmcnt(0)\n\ts_barrier" ::: "memory")
#define LDS_WAIT() asm volatile("s_waitcnt lgkmcnt(0)" ::: "memory")
typedef short v4i16_t __attribute__((ext_vector_type(4)));
__device__ __forceinline__ s16x4 vtr(lds_cptr p) { return __builtin_bit_cast(s16x4, __builtin_amdgcn_ds_read_tr16_b64_v4i16((LAS v4i16_t*)p)); }
#define MFMA32(a, b, c) __builtin_amdgcn_mfma_f32_32x32x16_bf16((a), (b), (c), 0, 0, 0)

__device__ __forceinline__ void pack_p(bf16x8 (&pf)[4], const f32x16& p0, const f32x16& p1) {
    u32x4 w;
    w.x = cvtpk(p0[0], p0[1]); w.y = cvtpk(p0[2], p0[3]); w.z = cvtpk(p0[4], p0[5]); w.w = cvtpk(p0[6], p0[7]); pf[0] = __builtin_bit_cast(bf16x8, w);
    w.x = cvtpk(p0[8], p0[9]); w.y = cvtpk(p0[10], p0[11]); w.z = cvtpk(p0[12], p0[13]); w.w = cvtpk(p0[14], p0[15]); pf[1] = __builtin_bit_cast(bf16x8, w);
    w.x = cvtpk(p1[0], p1[1]); w.y = cvtpk(p1[2], p1[3]); w.z = cvtpk(p1[4], p1[5]); w.w = cvtpk(p1[6], p1[7]); pf[2] = __builtin_bit_cast(bf16x8, w);
    w.x = cvtpk(p1[8], p1[9]); w.y = cvtpk(p1[10], p1[11]); w.z = cvtpk(p1[12], p1[13]); w.w = cvtpk(p1[14], p1[15]); pf[3] = __builtin_bit_cast(bf16x8, w);
}
constexpr int ASLOT = 32768;
__device__ __forceinline__ void attnA_unit(const int wave_, LAS unsigned char* lds, unsigned lds0, const int s0, const int pre, LAS int* nextw, const LAS int* cuts, const LAS int* utab, unsigned* qheads, const int xcc, bf16x8 (&qio)[4],
                                           int b, int h, int qb, int t_lo, float smax2,
                                           const bf16_t* QA, const bf16_t* KA, const bf16_t* VA, const bf16_t* ZA, bf16_t* OA, const float* subg, float lam) {
    const int tid = my_tid(wave_);
    const int lane = tid & 63, r32 = lane & 31, hi = lane >> 5;
    const int wid = wave_, j = wid >> 2, wq = wid & 3;
    const int q0 = qb * 128, NT = (q0 + 128) / 64 - t_lo;
    const size_t rowbase = (size_t)b * SEQ;
    const int qloc = 32 * wq + r32, qpos = q0 + qloc;
    const float slope2 = exp2f(-(float)(h + 1)) * LOG2E;
    bf16x8 qf[4];
    if (pre) {
#pragma unroll
        for (int d0 = 0; d0 < 4; ++d0) qf[d0] = qio[d0];
    } else { const bf16_t* Qw = QA + (rowbase + qpos) * 1024 + (2 * h + j) * 64 + hi * 8;
#pragma unroll
      for (int d0 = 0; d0 < 4; ++d0) qf[d0] = *(const bf16x8*)(Qw + d0 * 16); }
    const int krow = 8 * wid + (lane >> 3), kch = (lane & 7) ^ ((krow >> 1) & 7);
    const bf16_t* ksrc0 = KA + ((size_t)(b * 16 + 2 * h) * SEQ + krow) * 64 + kch * 8;
    const int pva = 2 * wid, pvb = 2 * wid + 1, vch = (lane & 15) ^ (((lane >> 4) & 3) << 2);
    const bf16_t* vsrcA = VA + ((size_t)(b * 8 + h) * SEQ + 4 * pva + (lane >> 4)) * 128 + vch * 8;
    const bf16_t* vsrcB = vsrcA + 4 * 128;
    const int klane = krow * 64 + kch * 8, vlane = (4 * pva + (lane >> 4)) * 128 + vch * 8;
    const unsigned kdst = lds0 + wid * 1024, vdstA = lds0 + 16384 + pva * 1024, vdstB = lds0 + 16384 + pvb * 1024;
#define DMA_TILE(t, sl) do { const size_t ko_ = (size_t)(t) * 64 * 64, vo_ = (size_t)(t) * 64 * 128; const unsigned so_ = (unsigned)(sl) * ASLOT; \
        GLDS(ksrc0 + ko_, kdst + so_); GLDS(ksrc0 + (size_t)SEQ * 64 + ko_, kdst + 8192 + so_); GLDS(vsrcA + vo_, vdstA + so_); GLDS(vsrcB + vo_, vdstB + so_); } while (0)
    asm volatile("" ::: "memory");
    if (!pre) { DMA_TILE(t_lo, s0);
        if (NT > 1) DMA_TILE(t_lo + 1, s0 + 1); }
    if (NT > 2) DMA_TILE(t_lo + 2, (s0 + 2) & 3);
    f32x16 bias0;
#pragma unroll
    for (int r = 0; r < 16; ++r) bias0[r] = slope2 * (float)(crow(r, hi) - qloc);
    const float s32 = 32.f * slope2;
    float l = 0.f;
    f32x16 o[4];
#pragma unroll
    for (int db = 0; db < 4; ++db)
#pragma unroll
        for (int r = 0; r < 16; ++r) o[db][r] = 0.f;
    const int kofs = j * 8192 + r32 * 128;
    const int kx0 = (hi ^ ((r32 >> 1) & 7)) * 16;
    const int vx0 = 256 * (4 * hi + ((lane & 15) >> 2)) + 16 * (4 * ((lane >> 2) & 3) + 2 * ((lane >> 4) & 1) + ((lane >> 1) & 1)) + 8 * (lane & 1);
    const int qfirst = q0 + 32 * wq, qlast = qfirst + 31;
    const int NTw = (64 * (t_lo + NT - 1) <= qlast) ? NT : NT - 1;
    f32x16 p0, p1;
#define SB0() __builtin_amdgcn_sched_barrier(0)
#define PINV(x) asm volatile("" : "+v"(x))
#define KLD(kf, sl, d0) do { const lds_cptr kb_ = (lds_cptr)lds + (sl) * ASLOT + kofs + (kx0 ^ (32 * (d0))); kf[0] = *(const LAS bf16x8*)(kb_); kf[1] = *(const LAS bf16x8*)(kb_ + 4096); } while (0)
    struct VF1 { s16x4 lo, hh; };
#define VLD1(vf, sl, g_) do { const lds_cptr vb_ = (lds_cptr)lds + (sl) * ASLOT + 16384 + (vx0 ^ (64 * ((g_) >> 2))) + ((g_) & 3) * 4096; vf.lo = vtr(vb_); vf.hh = vtr(vb_ + 2048); } while (0)
#define VF8(vf) ((bf16x8){vf.lo[0], vf.lo[1], vf.lo[2], vf.lo[3], vf.hh[0], vf.hh[1], vf.hh[2], vf.hh[3]})
#define QK8(sl) do { bf16x8 ka[2], kb2[2], kc[2], kd[2]; \
        KLD(ka, sl, 0); KLD(kb2, sl, 1); KLD(kc, sl, 2); KLD(kd, sl, 3); SB0(); \
        p0 = MFMA32(ka[0], qf[0], bias0); p1 = MFMA32(ka[1], qf[0], bias0); p0 = MFMA32(kb2[0], qf[1], p0); p1 = MFMA32(kb2[1], qf[1], p1); \
        p0 = MFMA32(kc[0], qf[2], p0); p1 = MFMA32(kc[1], qf[2], p1); p0 = MFMA32(kd[0], qf[3], p0); p1 = MFMA32(kd[1], qf[3], p1); SB0(); } while (0)
#define KLOADS(sl) bf16x8 ka[2], kb2[2], kc[2], kd[2]; KLD(ka, sl, 0); KLD(kb2, sl, 1); KLD(kc, sl, 2); KLD(kd, sl, 3); SB0()
#define QKMMA() do { p0 = MFMA32(ka[0], qf[0], bias0); p1 = MFMA32(ka[1], qf[0], bias0); p0 = MFMA32(kb2[0], qf[1], p0); p1 = MFMA32(kb2[1], qf[1], p1); \
        p0 = MFMA32(kc[0], qf[2], p0); p1 = MFMA32(kc[1], qf[2], p1); p0 = MFMA32(kd[0], qf[3], p0); p1 = MFMA32(kd[1], qf[3], p1); SB0(); } while (0)
#define MASK(t) do { if (64 * (t) + 63 > qfirst) { const int qh = qpos - 64 * (t) - 4 * hi; \
            _Pragma("unroll") for (int r = 0; r < 16; ++r) { const int cr = (r & 3) + 8 * (r >> 2); if (cr > qh) p0[r] = -INFINITY; if (cr + 32 > qh) p1[r] = -INFINITY; } SB0(); } } while (0)
    u32x4 pc0, pc1, pc2, pc3;
    if (NT > 2) { WAIT_BAR(4); } else { WAIT_BAR(0); }
    int pend = 1 << 20; if (tid == 0) pend = (int)atomicAdd(qheads + 64 * b, 1u);
    QK8(s0); MASK(t_lo);
    { const float c0 = slope2 * (float)(64 * t_lo - q0) - smax2, c1 = c0 + s32; float rs = 0.f;
#pragma unroll
      for (int r = 0; r < 16; ++r) { p0[r] = __builtin_amdgcn_exp2f(p0[r] + c0); p1[r] = __builtin_amdgcn_exp2f(p1[r] + c1); rs += p0[r] + p1[r]; }
      l += rs;
      pc0 = (u32x4){cvtpk(p0[0], p0[1]), cvtpk(p0[2], p0[3]), cvtpk(p0[4], p0[5]), cvtpk(p0[6], p0[7])};
      pc1 = (u32x4){cvtpk(p0[8], p0[9]), cvtpk(p0[10], p0[11]), cvtpk(p0[12], p0[13]), cvtpk(p0[14], p0[15])};
      pc2 = (u32x4){cvtpk(p1[0], p1[1]), cvtpk(p1[2], p1[3]), cvtpk(p1[4], p1[5]), cvtpk(p1[6], p1[7])};
      pc3 = (u32x4){cvtpk(p1[8], p1[9]), cvtpk(p1[10], p1[11]), cvtpk(p1[12], p1[13]), cvtpk(p1[14], p1[15])}; SB0(); }
    for (int i = 0; i + 1 < NTw; ++i) {
        const int t = t_lo + i;
        if (i + 2 < NT) { WAIT_BAR(4); } else { WAIT_BAR(0); }
        {
            const int sv = (i + s0) & 3;
            KLOADS((i + 1 + s0) & 3);
            VF1 vcur, vn1; VLD1(vcur, sv, 0); VLD1(vn1, sv, 1); SB0();
            if (i + 3 < NT) DMA_TILE(t + 3, (i + 3 + s0) & 3);
            const bf16x8 q0_ = __builtin_bit_cast(bf16x8, pc0), q1_ = __builtin_bit_cast(bf16x8, pc1), q2_ = __builtin_bit_cast(bf16x8, pc2), q3_ = __builtin_bit_cast(bf16x8, pc3);
            SB0();
            QKMMA(); MASK(t + 1);
            const float c0 = slope2 * (float)(64 * (t + 1) - q0) - smax2, c1 = c0 + s32; float rs = 0.f;
            u32x4 n0, n1, n2, n3;
#pragma unroll
            for (int g = 0; g < 16; ++g) {
                VF1 vn2; if (g < 14) VLD1(vn2, sv, g + 2);
                const bf16x8 pk_ = (g & 3) == 0 ? q0_ : (g & 3) == 1 ? q1_ : (g & 3) == 2 ? q2_ : q3_;
                o[g >> 2] = MFMA32(VF8(vcur), pk_, o[g >> 2]);
                p0[g] = __builtin_amdgcn_exp2f(p0[g] + c0); p1[g] = __builtin_amdgcn_exp2f(p1[g] + c1); rs += p0[g] + p1[g];
                PINV(p0[g]); PINV(p1[g]); PINV(rs);
                if (g & 1) { const unsigned wa = cvtpk(p0[g - 1], p0[g]), wb = cvtpk(p1[g - 1], p1[g]); const int k = g >> 1;
                    if (k < 4) { n0[k & 3] = wa; n2[k & 3] = wb; } else { n1[k & 3] = wa; n3[k & 3] = wb; } }
                SB0();
                vcur = vn1; if (g < 14) vn1 = vn2;
            }
            l += rs;
            pc0 = n0; pc1 = n1; pc2 = n2; pc3 = n3;
        }
    }
    {
        const int i = NTw - 1;
        if (i + 2 < NT) { WAIT_BAR(4); } else { WAIT_BAR(0); }
        if (i + 3 < NT) DMA_TILE(t_lo + i + 3, (i + 3 + s0) & 3);
        const int sv = (i + s0) & 3;
        const bf16x8 q0_ = __builtin_bit_cast(bf16x8, pc0), q1_ = __builtin_bit_cast(bf16x8, pc1), q2_ = __builtin_bit_cast(bf16x8, pc2), q3_ = __builtin_bit_cast(bf16x8, pc3);
        VF1 vcur; VLD1(vcur, sv, 0);
#pragma unroll
        for (int g = 0; g < 16; ++g) {
            VF1 vnx; if (g < 15) VLD1(vnx, sv, g + 1);
            const bf16x8 pk_ = (g & 3) == 0 ? q0_ : (g & 3) == 1 ? q1_ : (g & 3) == 2 ? q2_ : q3_;
            o[g >> 2] = MFMA32(VF8(vcur), pk_, o[g >> 2]);
            SB0();
            if (g < 15) vcur = vnx;
        }
    }
    if (NTw < NT) { WAIT_BAR(0); }
#undef KLD
#undef VLD1
#undef VF8
#undef QK8
#undef KLOADS
#undef QKMMA
#undef MASK
#undef PINV
#undef DMA_TILE
    l = half_swap_sum(l);
    const float rl = 1.0f / l;
    if (my_tid(wave_) == 0) {
        int d_ = -1;
        if (pend < 512) d_ = (b << 16) | utab[pend];
        else for (int qi_ = ((b - xcc) & 7) + 1; qi_ < 8; ++qi_) { const int bq_ = (xcc + qi_) & 7; const int ix_ = (int)atomicAdd(qheads + 64 * bq_, 1u); if (ix_ < 512) { d_ = (bq_ << 16) | utab[ix_]; break; } }
        *nextw = d_;
    }
    WAIT_BAR(0);
    const int lane2 = my_tid(wave_) & 63, hi2 = lane2 >> 5;
    {
        const int nd = *nextw;
        if (nd >= 0) {
            const int nb = nd >> 16, nh = (nd >> 6) & 7, nqb = nd & 63, ndd = nqb * 128 - cuts[nh], ntl = ndd > 0 ? ndd >> 6 : 0, nNT = 2 * nqb + 2 - ntl;
            const bf16_t* nk = KA + (size_t)(nb * 16 + 2 * nh) * SEQ * 64 + klane + (size_t)ntl * 64 * 64;
            const bf16_t* nv = VA + (size_t)(nb * 8 + nh) * SEQ * 128 + vlane + (size_t)ntl * 64 * 128;
            const unsigned so_ = (unsigned)(s0 ^ 2) * ASLOT;
            GLDS(nk, kdst + so_); GLDS(nk + (size_t)SEQ * 64, kdst + 8192 + so_); GLDS(nv, vdstA + so_); GLDS(nv + 4 * 128, vdstB + so_);
            if (nNT > 1) { GLDS(nk + 64 * 64, kdst + so_ + ASLOT); GLDS(nk + (size_t)SEQ * 64 + 64 * 64, kdst + 8192 + so_ + ASLOT); GLDS(nv + 64 * 128, vdstA + so_ + ASLOT); GLDS(nv + 64 * 128 + 4 * 128, vdstB + so_ + ASLOT); }
            const bf16_t* Qn = QA + ((size_t)nb * SEQ + nqb * 128 + 32 * wq + (lane2 & 31)) * 1024 + (2 * nh + j) * 64 + hi2 * 8;
#pragma unroll
            for (int d0 = 0; d0 < 4; ++d0) qio[d0] = *(const bf16x8*)(Qn + d0 * 16);
        }
    }
    LAS float* xch = (LAS float*)(lds + s0 * ASLOT) + wq * 4096 + lane2;
    if (j == 1) {
#pragma unroll
        for (int db = 0; db < 4; ++db)
#pragma unroll
            for (int r = 0; r < 16; ++r) xch[(db * 16 + r) * 64] = o[db][r] * rl;
    }
    WAIT_BAR(0);
    if (j == 0) {
        float ss = 0.f;
#pragma unroll
        for (int db = 0; db < 4; ++db) {
            SB0();
#pragma unroll
            for (int r = 0; r < 16; ++r) { const float v = o[db][r] * rl - lam * xch[(db * 16 + r) * 64]; o[db][r] = v; ss += v * v; }
        }
        ss = half_swap_sum(ss);
        const float rstd = rsqrtf(ss * (1.0f / 128.0f) + 1e-6f) * 0.8f;
        const size_t rowoff = ((size_t)b * SEQ + q0 + 32 * wq + (lane2 & 31)) * 1024 + h * 128;
#pragma unroll
        for (int db = 0; db < 4; ++db) {
            SB0();
#pragma unroll
            for (int rg = 0; rg < 4; ++rg) {
                const int d = 32 * db + 8 * rg + 4 * hi2;
                const f32x4 g = *(const f32x4*)(subg + d);
                const u32x2 zz = *(const u32x2*)(ZA + rowoff + d);
                const float v0 = o[db][4 * rg + 0] * rstd * g[0] * bf_lo(zz.x), v1 = o[db][4 * rg + 1] * rstd * g[1] * bf_hi(zz.x);
                const float v2 = o[db][4 * rg + 2] * rstd * g[2] * bf_lo(zz.y), v3 = o[db][4 * rg + 3] * rstd * g[3] * bf_hi(zz.y);
                u32x2 w; w.x = cvtpk(v0, v1); w.y = cvtpk(v2, v3);
                *(u32x2*)(OA + rowoff + d) = w;
            }
        }
    }
    WAIT_BAR(0);
}

__device__ __forceinline__ void attnB_stage(const int wave_, const int lane, unsigned bufaddr, int b, int kvh, int nb, const bf16_t* KVS) {
    const int krow = 8 * wave_ + (lane >> 3), kch = (lane & 7) ^ ((krow >> 1) & 7), vch = (lane & 7) ^ (((krow >> 1) & 1) << 2);
    const long row0 = (long)b * SEQ + 128L * (nb - 1) + krow;
    const bf16_t* ksrc = KVS + row0 * 256 + kvh * 64 + kch * 8;
    const bf16_t* vsrc = KVS + row0 * 256 + 128 + kvh * 64 + vch * 8;
    for (int bt = (nb == 0 ? 2 : 0); bt < 4; ++bt) { GLDS(ksrc + (size_t)bt * 64 * 256, bufaddr + bt * 16384 + wave_ * 1024); GLDS(vsrc + (size_t)bt * 64 * 256, bufaddr + bt * 16384 + 8192 + wave_ * 1024); }
}
__device__ __forceinline__ void attnB_unit(const int wave_, LAS unsigned char* buf, int b, int kvh, int nb, float smax2,
                                           const bf16_t* QB, const bf16_t* ZB, bf16_t* OB, const float* sinks) {
    const int tid = my_tid(wave_);
    const int lane = tid & 63, r32 = lane & 31, hi = lane >> 5;
    const int hq = kvh * 8 + wave_;
    const size_t rowbase = (size_t)b * SEQ;
    const float slope2 = exp2f(-0.5f * (float)(hq + 1)) * LOG2E, sink2 = sinks[hq] * LOG2E;
    const float ref = fmaxf(smax2, sink2), psink = __builtin_amdgcn_exp2f(sink2 - ref);
    const int bt0 = nb == 0 ? 2 : 0;
    const int kx0 = r32 * 128 + (hi ^ ((r32 >> 1) & 7)) * 16;
    const int rq = (lane & 15) >> 2;
    const int vx0 = 8192 + 128 * (4 * hi + rq) + 64 * (rq >> 1) + 32 * ((lane >> 4) & 1) + 8 * (lane & 3);
    const int qh = r32 - 4 * hi;
    f32x16 biasB;
#pragma unroll
    for (int r = 0; r < 16; ++r) biasB[r] = slope2 * (float)((r & 3) + 8 * (r >> 2));
    bf16x8 qf[4], qn[4];
    { const bf16_t* Qp = QB + (rowbase + nb * 128 + r32) * 1024 + hq * 64 + hi * 8;
#pragma unroll
      for (int d0 = 0; d0 < 4; ++d0) qf[d0] = *(const bf16x8*)(Qp + d0 * 16); }
    for (int rb = 0; rb < 4; ++rb) {
        const size_t rowoff = (rowbase + nb * 128 + 32 * rb + r32) * 1024 + hq * 64;
        if (rb < 3) {
#pragma unroll
            for (int d0 = 0; d0 < 4; ++d0) qn[d0] = *(const bf16x8*)(QB + rowoff + 32 * 1024 + d0 * 16 + hi * 8);
        }
        u32x2 zz[2][4];
#pragma unroll
        for (int db = 0; db < 2; ++db)
#pragma unroll
            for (int rg = 0; rg < 4; ++rg) zz[db][rg] = *(const u32x2*)(ZB + rowoff + 32 * db + 8 * rg + 4 * hi);
        float l = hi == 0 ? psink : 0.0f;
        f32x16 o[2];
#pragma unroll
        for (int db = 0; db < 2; ++db)
#pragma unroll
            for (int r = 0; r < 16; ++r) o[db][r] = 0.f;
        for (int tt = 0; tt < 3; ++tt) {
            const int bt = (rb >> 1) + tt;
            if (bt < bt0) continue;
            const lds_cptr tb = (lds_cptr)buf + bt * 16384;
            f32x16 p0, p1;
            { bf16x8 ka[2], kb2[2], kc[2], kd[2];
              ka[0] = *(const LAS bf16x8*)(tb + kx0); ka[1] = *(const LAS bf16x8*)(tb + kx0 + 4096);
              kb2[0] = *(const LAS bf16x8*)(tb + (kx0 ^ 32)); kb2[1] = *(const LAS bf16x8*)(tb + (kx0 ^ 32) + 4096);
              kc[0] = *(const LAS bf16x8*)(tb + (kx0 ^ 64)); kc[1] = *(const LAS bf16x8*)(tb + (kx0 ^ 64) + 4096);
              kd[0] = *(const LAS bf16x8*)(tb + (kx0 ^ 96)); kd[1] = *(const LAS bf16x8*)(tb + (kx0 ^ 96) + 4096);
              __builtin_amdgcn_sched_barrier(0);
              p0 = MFMA32(ka[0], qf[0], biasB); p1 = MFMA32(ka[1], qf[0], biasB); p0 = MFMA32(kb2[0], qf[1], p0); p1 = MFMA32(kb2[1], qf[1], p1);
              p0 = MFMA32(kc[0], qf[2], p0); p1 = MFMA32(kc[1], qf[2], p1); p0 = MFMA32(kd[0], qf[3], p0); p1 = MFMA32(kd[1], qf[3], p1);
              __builtin_amdgcn_sched_barrier(0); }
            s16x4 lo_, hh_, lo1_, hh1_;
            lo_ = vtr(tb + vx0); hh_ = vtr(tb + vx0 + 1024); lo1_ = vtr(tb + vx0 + 2048); hh1_ = vtr(tb + vx0 + 2048 + 1024);
            __builtin_amdgcn_sched_barrier(0);
            const int D0 = 128 + 32 * rb - 64 * bt;
            const float c0 = -slope2 * (float)(D0 + qh) - ref, c1 = c0 + 32.f * slope2;
            float rs = 0.f;
#pragma unroll
            for (int r = 0; r < 16; ++r) { p0[r] = __builtin_amdgcn_exp2f(p0[r] + c0); p1[r] = __builtin_amdgcn_exp2f(p1[r] + c1); }
#define MASKH(P, Dn) do { if ((Dn) == 128) { _Pragma("unroll") for (int r = 0; r < 16; ++r) { const int cr = (r & 3) + 8 * (r >> 2); if (!(cr > qh)) P[r] = 0.f; } } \
                else if ((Dn) == 0) { _Pragma("unroll") for (int r = 0; r < 16; ++r) { const int cr = (r & 3) + 8 * (r >> 2); if (cr > qh) P[r] = 0.f; } } \
                else if ((Dn) < 0 || (Dn) > 128) { _Pragma("unroll") for (int r = 0; r < 16; ++r) P[r] = 0.f; } } while (0)
            MASKH(p0, D0); MASKH(p1, D0 - 32);
#undef MASKH
#pragma unroll
            for (int r = 0; r < 16; ++r) rs += p0[r] + p1[r];
            l += rs;
            bf16x8 pf[4]; pack_p(pf, p0, p1);
            __builtin_amdgcn_sched_barrier(0);
            {
                s16x4 lo2_, hh2_;
#pragma unroll
                for (int g = 0; g < 8; ++g) {
                    if (g < 6) { const int g2 = g + 2; lo2_ = vtr(tb + (vx0 ^ (64 * (g2 >> 2))) + (g2 & 3) * 2048); hh2_ = vtr(tb + (vx0 ^ (64 * (g2 >> 2))) + (g2 & 3) * 2048 + 1024); }
                    const bf16x8 vf = (bf16x8){lo_[0], lo_[1], lo_[2], lo_[3], hh_[0], hh_[1], hh_[2], hh_[3]};
                    o[g >> 2] = MFMA32(vf, pf[g & 3], o[g >> 2]);
                    __builtin_amdgcn_sched_barrier(0);
                    lo_ = lo1_; hh_ = hh1_; if (g < 6) { lo1_ = lo2_; hh1_ = hh2_; }
                }
            }
        }
        l = half_swap_sum(l);
        const float rl = 1.0f / l;
#pragma unroll
        for (int db = 0; db < 2; ++db)
#pragma unroll
            for (int rg = 0; rg < 4; ++rg) {
                const int d = 32 * db + 8 * rg + 4 * hi;
                const u32x2 z_ = zz[db][rg];
                const float v0 = o[db][4 * rg + 0] * rl * bf_lo(z_.x), v1 = o[db][4 * rg + 1] * rl * bf_hi(z_.x);
                const float v2 = o[db][4 * rg + 2] * rl * bf_lo(z_.y), v3 = o[db][4 * rg + 3] * rl * bf_hi(z_.y);
                u32x2 w; w.x = cvtpk(v0, v1); w.y = cvtpk(v2, v3);
                *(u32x2*)(OB + rowoff + d) = w;
            }
        if (rb < 3) {
#pragma unroll
            for (int d0 = 0; d0 < 4; ++d0) qf[d0] = qn[d0];
        }
    }
}

__device__ __forceinline__ int permrow(int a) { const int r = a & 255; return (a & ~255) + ((r >> 5) & 1) * 128 + (r >> 6) * 32 + (r & 31); }
__device__ __forceinline__ void p0_transpose_item(const float* W, int K, int N, bf16_t* WT, LAS float* scr, int item, int lane, const float* kgain = nullptr, const float* kscale = nullptr) {
    const int nblk = N / 32, kb = item / nblk, nb = item - kb * nblk, k0 = 64 * kb, n0 = 32 * nb;
#pragma unroll 8
    for (int i = 0; i < 32; ++i) { const int kk = 2 * i + (lane >> 5); scr[kk * 33 + (lane & 31)] = W[(size_t)(k0 + kk) * N + n0 + (lane & 31)]; }
    LDS_WAIT();
    const int c = lane & 7;
    const int prow0 = permrow(n0);
#pragma unroll
    for (int jj = 0; jj < 4; ++jj) { const int n = (lane >> 3) + 8 * jj; const LAS float* s = scr + (8 * c) * 33 + n;
        f32x4 m0 = {1.f, 1.f, 1.f, 1.f}, m1 = {1.f, 1.f, 1.f, 1.f};
        if (kgain) { m0 = *(const f32x4*)(kgain + k0 + 8 * c) * (*(const f32x4*)(kscale + k0 + 8 * c) + 1.0f); m1 = *(const f32x4*)(kgain + k0 + 8 * c + 4) * (*(const f32x4*)(kscale + k0 + 8 * c + 4) + 1.0f); }
        u32x4 o; o.x = cvtpk(s[0 * 33] * m0[0], s[1 * 33] * m0[1]); o.y = cvtpk(s[2 * 33] * m0[2], s[3 * 33] * m0[3]); o.z = cvtpk(s[4 * 33] * m1[0], s[5 * 33] * m1[1]); o.w = cvtpk(s[6 * 33] * m1[2], s[7 * 33] * m1[3]);
        *(u32x4*)(WT + (size_t)(prow0 + n) * K + k0 + 8 * c) = o; }
    LDS_WAIT();
}
template <bool TWO, bool IN_BF16> __device__ __forceinline__ void norm_chunk(const void* Xv, int chunk, int lane,
        const float* g1, const float* sh1, const float* sc1, bf16_t* out1, const float* g2, const float* sh2, const float* sc2, bf16_t* out2, float* rstd_out = nullptr) {
    f32x4 A1[4], S1[4], A2[4], S2[4];
#pragma unroll
    for (int jj = 0; jj < 4; ++jj) { const int col = 4 * lane + 256 * jj;
        A1[jj] = *(const f32x4*)(g1 + col) * (*(const f32x4*)(sc1 + col) + 1.0f); S1[jj] = *(const f32x4*)(sh1 + col);
        if (TWO) { A2[jj] = *(const f32x4*)(g2 + col) * (*(const f32x4*)(sc2 + col) + 1.0f); S2[jj] = *(const f32x4*)(sh2 + col); } }
    for (int rr = 0; rr < 32; ++rr) {
        const size_t row = (size_t)chunk * 32 + rr;
        f32x4 v[4]; float ss = 0.f;
#pragma unroll
        for (int jj = 0; jj < 4; ++jj) {
            if (IN_BF16) { const u32x2 w = *(const u32x2*)((const bf16_t*)Xv + row * 1024 + 4 * lane + 256 * jj); v[jj] = (f32x4){bf_lo(w.x), bf_hi(w.x), bf_lo(w.y), bf_hi(w.y)}; }
            else v[jj] = *(const f32x4*)((const float*)Xv + row * 1024 + 4 * lane + 256 * jj);
            ss += (v[jj][0] * v[jj][0] + v[jj][1] * v[jj][1]) + (v[jj][2] * v[jj][2] + v[jj][3] * v[jj][3]); }
        const float rstd = rsqrtf(wave_sum(ss) * (1.0f / 1024.0f) + 1e-6f);
        if (rstd_out && lane == 0) rstd_out[row] = rstd;
#pragma unroll
        for (int jj = 0; jj < 4; ++jj) {
            const f32x4 xn = v[jj] * rstd;
            if (out1) { const f32x4 u = xn * A1[jj] + S1[jj]; u32x2 w; w.x = cvtpk(u[0], u[1]); w.y = cvtpk(u[2], u[3]); *(u32x2*)(out1 + row * 1024 + 4 * lane + 256 * jj) = w; }
            if (TWO) { const f32x4 u = xn * A2[jj] + S2[jj]; u32x2 w; w.x = cvtpk(u[0], u[1]); w.y = cvtpk(u[2], u[3]); *(u32x2*)(out2 + row * 1024 + 4 * lane + 256 * jj) = w; }
        }
    }
}

struct RowOrder {
    int nM, nN, G, c;
    __device__ void init(int M, int N, int G_, int c_) { nM = M / 256; nN = N / 256; G = G_; c = c_; }
    __device__ bool next(int i, pg8::Unit& u) const { const int pm = c + (i / nN) * G; if (pm >= nM) return false; u.pm = pm; u.pn = i % nN; return true; }
    __device__ __forceinline__ void a_ready(const pg8::Unit&) const {}
    __device__ __forceinline__ void done(const pg8::Unit&) const {}
};
struct Params { const float* in[26]; float* out; unsigned char* ws; int ph_lo, ph_hi; };

__global__ void __launch_bounds__(NTHREADS) yoco_fwd(Params P) {
    extern __shared__ __attribute__((aligned(16))) unsigned char lds_raw[];
    LAS unsigned char* lds = (LAS unsigned char*)lds_raw;
    const unsigned lds0 = (unsigned)(uintptr_t)lds_raw;
    LAS unsigned char* ring = lds + 16384; const unsigned ring0 = lds0 + 16384u;
    cg::grid_group grid = cg::this_grid();
    const int wave = __builtin_amdgcn_readfirstlane(threadIdx.x >> 6);
    const int G = gridDim.x, bx = blockIdx.x;
    const int vcu = (G % 8 == 0) ? (bx % 8) * (G / 8) + bx / 8 : bx;
    const int gw = vcu * 8 + wave, NGW = G * 8;
    unsigned char* ws = P.ws;
    const float* x = P.in[0];
    float* modA = (float*)(ws + WS_MOD); float* modKV = modA + 8 * 3072; float* modB = modKV + 8 * 2048;
    float* ctlf = (float*)(ws + WS_CTL);
    bf16_t* WinA = (bf16_t*)(ws + WS_WINA); bf16_t* WoutA = (bf16_t*)(ws + WS_WOUTA); bf16_t* Wkv = (bf16_t*)(ws + WS_WKV); bf16_t* WinB = (bf16_t*)(ws + WS_WINB); bf16_t* WoutB = (bf16_t*)(ws + WS_WOUTB);
    bf16_t* R0 = (bf16_t*)(ws + WS_R0); bf16_t* R1 = (bf16_t*)(ws + WS_R1); bf16_t* R2 = (bf16_t*)(ws + WS_R2); bf16_t* R3 = (bf16_t*)(ws + WS_R3); bf16_t* R4 = (bf16_t*)(ws + WS_R4);
    float* H = (float*)(ws + WS_H);
    const int lo = P.ph_lo, hi_ = P.ph_hi;
#ifndef REP_MASK
#define REP_MASK 0
#endif
#define NREP(k) ((((REP_MASK) >> (k)) & 1) + 1)
#ifndef PH_MASK
#define PH_MASK 0x1ff
#endif
#define IN(k) (((PH_MASK >> (k)) & 1) && lo <= (k) && (k) < hi_)
    unsigned* const xbar = (unsigned*)ctlf + 4096;
    const unsigned xcc_id = (unsigned)__builtin_amdgcn_s_getreg((3 << 11) | 20) & 0xFu;
    volatile LAS unsigned* const xst = (volatile LAS unsigned*)(lds + 8192);
#define GBAR() grid_bar(xbar, xcc_id, xst, wave)
#define SEAM(k) do { if (IN(k) && IN((k) + 1)) { if ((k) == 0) { grid.sync(); if (my_tid(wave) == 0) { xst[0] = 0u; xst[1] = 0u; (void)xb_add(&xbar[XB_XCNT(xcc_id)], 1u); } } else GBAR(); } } while (0)

    if (IN(0)) {
        const int tid = my_tid(wave), lane = tid & 63;
        LAS float* sc = (LAS float*)lds;
        LAS float* red = (LAS float*)(lds + 32768);
        const float* c = P.in[1];
        for (int i = tid; i < 8192; i += NTHREADS) { const int bb = i >> 10, k = i & 1023; const float v = c[i]; sc[k * 8 + bb] = v / (1.0f + __expf(-v)); }
        __syncthreads();
        for (int cgp = bx; cgp < 256; cgp += G) {
            const int n0 = cgp * 32;
            const float* W; const float* bias; int N, nloc; float* dst;
            if (n0 < 3072) { W = P.in[3]; bias = P.in[4]; N = 3072; nloc = n0; dst = modA; }
            else if (n0 < 5120) { W = P.in[15]; bias = P.in[16]; N = 2048; nloc = n0 - 3072; dst = modKV; }
            else { W = P.in[20]; bias = P.in[21]; N = 3072; nloc = n0 - 5120; dst = modB; }
            const int col = tid & 31, ks = tid >> 5;
            f32x4 a0 = {0.f, 0.f, 0.f, 0.f}, a1 = {0.f, 0.f, 0.f, 0.f};
#pragma unroll 8
            for (int kk = 0; kk < 64; ++kk) { const int k = ks * 64 + kk; const float w = W[(size_t)k * N + nloc + col];
                const f32x4 s0 = *(const LAS f32x4*)(sc + k * 8), s1 = *(const LAS f32x4*)(sc + k * 8 + 4); a0 += s0 * w; a1 += s1 * w; }
#pragma unroll
            for (int e = 0; e < 4; ++e) { red[(ks * 8 + e) * 32 + col] = a0[e]; red[(ks * 8 + 4 + e) * 32 + col] = a1[e]; }
            __syncthreads();
            if (tid < 256) { const int bb = tid >> 5, cc = tid & 31; float s = bias[nloc + cc];
#pragma unroll
                for (int k2 = 0; k2 < 16; ++k2) s += red[(k2 * 8 + bb) * 32 + cc];
                dst[(size_t)bb * N + nloc + cc] = s; }
            __syncthreads();
        }
        if (bx == 0 && wave == 0) {
            float a = P.in[8][lane] * P.in[9][lane], bq = P.in[10][lane] * P.in[11][lane];
            a = wave_sum(a); bq = wave_sum(bq);
            if (lane == 0) ctlf[0] = __expf(a) - __expf(bq) + 0.2f;
            const float gq = P.in[6][lane], gk = P.in[7][lane];
            ctlf[64 + lane] = gq; ctlf[128 + lane] = gk;
            float mq = fabsf(gq), mk = fabsf(gk);
#pragma unroll
            for (int o_ = 1; o_ < 64; o_ <<= 1) { mq = fmaxf(mq, __shfl_xor(mq, o_)); mk = fmaxf(mk, __shfl_xor(mk, o_)); }
            const float smax2 = pg8::QK_C2 * 64.0f * mq * mk * 1.02f;
            if (lane == 0) ctlf[1] = smax2;
            { float mqb = fabsf(P.in[23][lane]), mkb = fabsf(P.in[18][lane]);
#pragma unroll
              for (int o_ = 1; o_ < 64; o_ <<= 1) { mqb = fmaxf(mqb, __shfl_xor(mqb, o_)); mkb = fmaxf(mkb, __shfl_xor(mkb, o_)); }
              if (lane == 0) ctlf[2] = pg8::QK_C2 * 64.0f * mqb * mkb * 1.02f; }
            if (lane < 8) { const float sl2 = exp2f(-(float)(lane + 1)) * LOG2E; const float cf = (2.0f * smax2 + 160.0f) / sl2;
                const int ci = cf > 1.0e6f ? 1000000 : (int)cf + 1; ((int*)ctlf)[16 + lane] = ci; ((LAS int*)(lds + 131072))[lane] = ci;
                ((unsigned*)ctlf)[256 + 64 * lane] = 0u; ((unsigned*)ctlf)[256 + 512 + 64 * lane] = 0u; }
        }
        __syncthreads();
        if (bx == 0) { for (int i_ = tid; i_ < XCD_BAR_WORDS; i_ += NTHREADS) ((unsigned*)ctlf)[4096 + i_] = 0u; }
        if (bx == 0) {
            LAS int* cuts = (LAS int*)(lds + 131072); LAS int* wk = cuts + 64;
            { const int hh = tid >> 6, qq = tid & 63, dd = qq * 128 - cuts[hh]; wk[tid] = 2 * qq + 2 - (dd > 0 ? dd >> 6 : 0); }
            __syncthreads();
            { const int mine = wk[tid]; int rank = 0;
              for (int k2 = 0; k2 < 512; ++k2) { const int wo = wk[k2]; rank += (wo > mine || (wo == mine && k2 < tid)) ? 1 : 0; }
              ((int*)ctlf)[2048 + rank] = tid; }
        }
        __syncthreads();
        LAS float* scr = (LAS float*)(lds + wave * 16384);
        constexpr int I_A = 16 * 128, I_OA = 16 * 32, I_KV = 16 * 8, I_B = 16 * 64, I_OB = 16 * 32;
        for (int it = gw; it < I_A + I_OA + I_KV + I_B + I_OB; it += NGW) {
            int r = it;
            if (r < I_A) { p0_transpose_item(P.in[5], 1024, 4096, WinA, scr, r, lane); continue; } r -= I_A;
            if (r < I_OA) { p0_transpose_item(P.in[13], 1024, 1024, WoutA, scr, r, lane); continue; } r -= I_OA;
            if (r < I_KV) { p0_transpose_item(P.in[17], 1024, 256, Wkv, scr, r, lane); continue; } r -= I_KV;
            if (r < I_B) { p0_transpose_item(P.in[22], 1024, 2048, WinB, scr, r, lane); continue; } r -= I_B;
            p0_transpose_item(P.in[25], 1024, 1024, WoutB, scr, r, lane);
        }
    }
    SEAM(0);
    bf16_t* const WkvB = (bf16_t*)(ws + 20 * MiB);
    float* const rstdH = (float*)(ws + 24 * MiB);
    float* const ckv = ctlf + 8192;
    if (IN(1)) for (int rep = 0; rep < NREP(1); ++rep) {
        if (rep) GBAR();
        const int lane = my_tid(wave) & 63;
        {
            LAS float* scr2 = (LAS float*)(ring + wave * 16384);
            for (int it = gw; it < 8 * 128; it += NGW) { const int bb = it >> 7;
                p0_transpose_item(P.in[17], 1024, 256, WkvB + (size_t)bb * 256 * 1024, scr2, it & 127, lane, P.in[14], modKV + bb * 2048 + 1024); }
            for (int d_ = gw; d_ < 2048; d_ += NGW) { const int bb = d_ >> 8, a_ = d_ & 255;
                const bf16_t* wr_ = Wkv + (size_t)permrow(a_) * 1024 + 16 * lane; const float* sh_ = modKV + bb * 2048 + 16 * lane;
                const u32x4 w0 = *(const u32x4*)wr_, w1 = *(const u32x4*)(wr_ + 8); float acc_ = 0.f;
                acc_ += bf_lo(w0.x) * sh_[0] + bf_hi(w0.x) * sh_[1] + bf_lo(w0.y) * sh_[2] + bf_hi(w0.y) * sh_[3] + bf_lo(w0.z) * sh_[4] + bf_hi(w0.z) * sh_[5] + bf_lo(w0.w) * sh_[6] + bf_hi(w0.w) * sh_[7];
                acc_ += bf_lo(w1.x) * sh_[8] + bf_hi(w1.x) * sh_[9] + bf_lo(w1.y) * sh_[10] + bf_hi(w1.y) * sh_[11] + bf_lo(w1.z) * sh_[12] + bf_hi(w1.z) * sh_[13] + bf_lo(w1.w) * sh_[14] + bf_hi(w1.w) * sh_[15];
                acc_ = wave_sum(acc_); if (lane == 0) ckv[d_] = acc_; }
        }
        for (int chunk = gw; chunk < MROWS / 32; chunk += NGW) {
            const int bb = chunk >> 8;
            norm_chunk<false, false>(x, chunk, lane, P.in[2], modA + bb * 3072, modA + bb * 3072 + 1024, R0, nullptr, nullptr, nullptr, nullptr);
        }
    }
    SEAM(1);
    if (IN(2)) for (int rep = 0; rep < NREP(2); ++rep) {
        if (rep) GBAR();
        pg8::Gemm g{R0, WinA, MROWS, 4096, 1024}; pg8::StaticOrder S; S.init(MROWS, 4096, G, bx);
        pg8::EpiProj E{R1, (size_t)(64 * MiB), ctlf + 64, 16, 1024, 0x03201102};
        pg8::gemm_phase<pg8::EpiProj, pg8::StaticOrder, true, true>(ring, g, S, E, wave);
    }
    SEAM(2);
    if (IN(3)) for (int rep = 0; rep < NREP(3); ++rep) {
        if (rep) GBAR();
        const float lam = ctlf[0], smax2 = ctlf[1];
        const int* ctli = (const int*)ctlf; unsigned* qheads = (unsigned*)ctlf + 256 + 512 * rep;
        LAS int* misc = (LAS int*)lds;
        const int xcc = (int)(__builtin_amdgcn_s_getreg((3 << 11) | 20) & 7u);
        { const int t0_ = my_tid(wave); if (t0_ < 8) misc[8 + t0_] = ctli[16 + t0_]; misc[64 + t0_] = ctli[2048 + t0_];
          if (t0_ == 0) { int d_ = -1; for (int qi_ = 0; qi_ < 8; ++qi_) { const int bq_ = (xcc + qi_) & 7; const int ix_ = (int)atomicAdd(qheads + 64 * bq_, 1u); if (ix_ < 512) { d_ = (bq_ << 16) | ctli[2048 + ix_]; break; } } misc[1] = d_; } }
        __syncthreads();
        int cur = misc[1], par = 0, s0 = 0, pre = 0;
        bf16x8 qio[4];
#pragma unroll
        for (int k = 0; k < 4; ++k) qio[k] = (bf16x8){0, 0, 0, 0, 0, 0, 0, 0};
        while (cur >= 0) {
            const int bq = cur >> 16, h = (cur >> 6) & 7, qb = cur & 63, dd = qb * 128 - misc[8 + h];
            attnA_unit(wave, ring, ring0, s0, pre, misc + 1 + (par ^ 1), misc + 8, misc + 64, qheads, xcc, qio, bq, h, qb, dd > 0 ? dd >> 6 : 0, smax2, R1, R2, R3, R4, R0, P.in[12], lam);
            cur = misc[1 + (par ^ 1)];
            par ^= 1; s0 ^= 2; pre = 1;
        }
    }
    SEAM(3);
    if (IN(4)) for (int rep = 0; rep < NREP(4); ++rep) {
        if (rep) GBAR();
        pg8::Gemm g{R0, WoutA, MROWS, 1024, 1024}; RowOrder S; S.init(MROWS, 1024, G, bx);
        pg8::EpiRes<false, true> E{x, (void*)H, modA + 2048, 3072};
        pg8::gemm_phase<pg8::EpiRes<false, true>, RowOrder, true, true>(ring, g, S, E, wave);
    }
    if (IN(5)) {
        asm volatile("s_waitcnt vmcnt(0)" ::: "memory"); __threadfence_block(); __syncthreads();
        bf16_t* UKVb = (bf16_t*)(ws + WS_H + 128 * MiB);
        const int lane = my_tid(wave) & 63;
        for (int pm = bx; pm < MROWS / 256; pm += G) {
            const int chunk = pm * 8 + wave, bb = chunk >> 8;
            norm_chunk<true, true>(H, chunk, lane, P.in[14], modKV + bb * 2048, modKV + bb * 2048 + 1024, nullptr, P.in[19], modB + bb * 3072, modB + bb * 3072 + 1024, R1, rstdH);
        }
        asm volatile("s_waitcnt vmcnt(0)" ::: "memory"); __threadfence_block(); __syncthreads();
        { pg8::Gemm g{(const bf16_t*)H, WkvB, MROWS, 256, 1024, (size_t)256 * 1024}; RowOrder S; S.init(MROWS, 256, G, bx);
          pg8::EpiProjT<true> E{R4, (size_t)128, P.in[18], 2, 256, 0x00000001, rstdH, ckv, 256};
          pg8::gemm_phase<pg8::EpiProjT<true>, RowOrder, true, true>(ring, g, S, E, wave); }
    }
    SEAM(5);
    if (IN(6)) for (int rep = 0; rep < NREP(6); ++rep) {
        if (rep) GBAR();
        { pg8::Gemm g{R1, WinB, MROWS, 2048, 1024}; pg8::StaticOrder S; S.init(MROWS, 2048, G, bx);
          pg8::EpiProj E{R2, (size_t)(64 * MiB), P.in[23], 16, 1024, 0x00000302};
          pg8::gemm_phase<pg8::EpiProj, pg8::StaticOrder, true, true>(ring, g, S, E, wave); }
    }
    SEAM(6);
    if (IN(7)) for (int rep = 0; rep < NREP(7); ++rep) {
        if (rep) GBAR();
        {
            const float smax2B = ctlf[2];
            const int lane_ = my_tid(wave) & 63;
            int u = vcu, par = 0;
            if (u < 1024) attnB_stage(wave, lane_, ring0, u >> 7, (u >> 6) & 1, u & 63, R4);
            for (; u < 1024; u += G, par ^= 1) {
                WAIT_BAR(0);
                if (u + G < 1024) { const int u2 = u + G; attnB_stage(wave, my_tid(wave) & 63, ring0 + (par ^ 1) * 65536u, u2 >> 7, (u2 >> 6) & 1, u2 & 63, R4); }
                attnB_unit(wave, ring + par * 65536, u >> 7, (u >> 6) & 1, u & 63, smax2B, R2, R3, R1, P.in[24]);
            }
            WAIT_BAR(0);
        }
    }
    SEAM(7);
    if (IN(8)) {
        pg8::Gemm g{R1, WoutB, MROWS, 1024, 1024}; pg8::StaticOrder S; S.init(MROWS, 1024, G, bx);
        pg8::EpiRes<true, false> E{H, P.out, modB + 2048, 3072};
        pg8::gemm_phase<pg8::EpiRes<true, false>, pg8::StaticOrder, true, true>(ring, g, S, E, wave);
    }
#undef IN
#undef SEAM
}

extern "C" void kernel_launch(void* const* d_in, const int* in_sizes, int n_in, void* d_out, int out_size, void* d_ws, size_t ws_size, hipStream_t stream) {
    static int grid = 0;
    if (grid == 0) {
        if (n_in != 26 || out_size != MROWS * DM || ws_size < WS_END) { fprintf(stderr, "kernel_launch: unexpected shapes (n_in %d out %d ws %zu)\n", n_in, out_size, ws_size); grid = -1; return; }
        int dev = 0, cus = 0, per_cu = 0;
        hipGetDevice(&dev); hipDeviceGetAttribute(&cus, hipDeviceAttributeMultiprocessorCount, dev);
        hipFuncSetAttribute((const void*)yoco_fwd, hipFuncAttributeMaxDynamicSharedMemorySize, LDS_BYTES);
        if (hipOccupancyMaxActiveBlocksPerMultiprocessor(&per_cu, (const void*)yoco_fwd, NTHREADS, LDS_BYTES) != hipSuccess || per_cu < 1) { fprintf(stderr, "kernel_launch: occupancy query gave %d\n", per_cu); per_cu = 1; }
        (void)hipGetLastError();
        grid = cus * per_cu;
    }
    if (grid < 0) return;
    Params p{};
    for (int i = 0; i < 26; ++i) p.in[i] = (const float*)d_in[i];
    p.out = (float*)d_out; p.ws = (unsigned char*)d_ws; p.ph_lo = 0; p.ph_hi = 9;
    void* args[] = {&p};
    hipError_t e = hipLaunchCooperativeKernel((const void*)yoco_fwd, dim3(grid), dim3(NTHREADS), args, LDS_BYTES, stream);
    if (e != hipSuccess) fprintf(stderr, "cooperative launch failed: %s (grid %d)\n", hipGetErrorString(e), grid);
}
```

```cpp
#include <hip/hip_runtime.h>
#include <hip/hip_cooperative_groups.h>
#include <cstdio>
#include <cstdint>
namespace cg = cooperative_groups;
namespace pg8 {
#define PG8_LAS __attribute__((address_space(3)))
typedef unsigned short bf16_t;
typedef short bf16x8 __attribute__((ext_vector_type(8)));
typedef float f32x4 __attribute__((ext_vector_type(4)));
typedef unsigned u32x4 __attribute__((ext_vector_type(4)));
constexpr int BM = 256, BK = 64, HALF = 128, HTB = HALF * BK * 2  , STAGE_BYTES = 8 * HTB, NXCD = 8, WGM = 8;

__host__ __device__ __forceinline__ int lds_byte(int r, int c) { const int st = (r >> 4) * 2 + (c >> 5), rr = r & 15, cc = c & 31, ob = rr * 64 + cc * 2; return st * 1024 + (ob ^ (((ob >> 9) & 1) << 5)); }
__host__ __device__ __forceinline__ void stage_rc(int b, int& R, int& C) { const int st = b / 1024, sb = b % 1024, swz = sb ^ (((sb >> 9) & 1) << 5); R = (st >> 1) * 16 + swz / 64; C = (st & 1) * 32 + (swz % 64) / 2; }
__host__ __device__ __forceinline__ int perm32(int rho) { const int n = rho >> 4, i = rho & 15; return 8 * (i >> 2) + 4 * n + (i & 3); }

struct Unit { int pm, pn; };
struct Gemm { const bf16_t* A; const bf16_t* Bt; int M, N, K; size_t bstride = 0; };

struct StaticOrder {
    int nM, nN, nwg, G, c;
    __host__ __device__ void init(int M, int N, int G_, int c_) { nM = M / BM; nN = N / BM; nwg = nM * nN; G = G_; c = c_; }
    __host__ __device__ bool next(int i, Unit& u) const {
        const long L = (long)i * G + c; if (L >= nwg) return false;
        int wgid = (int)L; { const int q = nwg / NXCD, r = nwg % NXCD, xcd = wgid % NXCD, off = wgid / NXCD; wgid = (xcd < r ? xcd * (q + 1) : r * (q + 1) + (xcd - r) * q) + off; }
        const int nig = WGM * nN, gid = wgid / nig, fm = gid * WGM, gsz = (nM - fm) < WGM ? (nM - fm) : WGM;
        u.pm = fm + ((wgid % nig) % gsz); u.pn = (wgid % nig) / gsz; return true;
    }
    __device__ __forceinline__ void a_ready(const Unit&) const {}
    __device__ __forceinline__ void done(const Unit&) const {}
};

__device__ __forceinline__ unsigned cvt_pk_bf16(float lo, float hi) { unsigned r; asm volatile("v_cvt_pk_bf16_f32 %0, %1, %2" : "=v"(r) : "v"(lo), "v"(hi)); return r; }
typedef unsigned u32x4e __attribute__((ext_vector_type(4)));
constexpr float QK_C2 = 0.125f * 1.4426950408889634f;
template <bool AFF> struct EpiProjT {
    static constexpr bool PERM = true, AFTER_DRAIN = false;
    bf16_t* out0; size_t tstride;
    const float* gtab;
    int hpt, ldo;
    int modes;
    const float* rstd = nullptr; const float* cbias = nullptr; int cb_ld = 0;
    __device__ __forceinline__ void operator()(const f32x4 (&acc)[2][2][4][2], const Unit& u, int wr, int wc, int fr, int fq) const {
        const int head = u.pn * 4 + wc, ty = head / hpt, hh = head - ty * hpt;
        bf16_t* base = out0 + (size_t)ty * tstride;
        const int mode = (modes >> (8 * ty)) & 15, lay = (modes >> (8 * ty + 4)) & 15;
        const float* g = gtab + 64 * ty;
        int row0 = u.pm * BM + wr * 64 + fr, colh = hh * 64 + 8 * fq, ldo = this->ldo;
        const int trow0 = row0;
        f32x4 cbv[2][2];
#pragma unroll
        for (int bj = 0; bj < 2; ++bj)
#pragma unroll
            for (int n = 0; n < 2; ++n) cbv[bj][n] = AFF ? *(const f32x4*)(cbias + (size_t)(u.pm >> 5) * cb_ld + head * 64 + 32 * bj + 8 * fq + 4 * n) : (f32x4){0.f, 0.f, 0.f, 0.f};
        if (lay == 1) { const int bb = row0 >> 13; row0 = (bb * hpt + hh) * 8192 + (row0 & 8191); colh = 8 * fq; ldo = 64; }
        else if (lay == 2) { const int bb = row0 >> 13; row0 = (bb * (hpt >> 1) + (hh >> 1)) * 8192 + (row0 & 8191); colh = (hh & 1) * 64 + 8 * fq; ldo = 128; }
        if (mode == 1 || mode == 2) {
            const float gs = mode == 2 ? QK_C2 : 1.0f;
            f32x4 gv[2][2];
#pragma unroll
            for (int bj = 0; bj < 2; ++bj)
#pragma unroll
                for (int n = 0; n < 2; ++n) gv[bj][n] = *(const f32x4*)(g + 32 * bj + 8 * fq + 4 * n) * gs;
#pragma unroll
            for (int ai = 0; ai < 2; ++ai)
#pragma unroll
                for (int m = 0; m < 4; ++m) {
                    const float rs_ = AFF ? rstd[trow0 + ai * HALF + m * 16] : 1.0f;
                    f32x4 xv[2][2];
                    float ss = 0.f;
#pragma unroll
                    for (int bj = 0; bj < 2; ++bj)
#pragma unroll
                        for (int n = 0; n < 2; ++n) { const f32x4 x = AFF ? acc[ai][bj][m][n] * rs_ + cbv[bj][n] : acc[ai][bj][m][n]; xv[bj][n] = x; ss += (x[0] * x[0] + x[1] * x[1]) + (x[2] * x[2] + x[3] * x[3]); }
                    { auto r16 = __builtin_amdgcn_permlane16_swap(__float_as_uint(ss), __float_as_uint(ss), false, false); ss = __uint_as_float(r16[0]) + __uint_as_float(r16[1]);
                      auto r32 = __builtin_amdgcn_permlane32_swap(__float_as_uint(ss), __float_as_uint(ss), false, false); ss = __uint_as_float(r32[0]) + __uint_as_float(r32[1]); }
                    const float rstd_h = rsqrtf(ss * (1.0f / 64.0f) + 1e-6f);
                    bf16_t* rowp = base + (size_t)(row0 + ai * HALF + m * 16) * ldo + colh;
#pragma unroll
                    for (int bj = 0; bj < 2; ++bj) { const f32x4 v0 = xv[bj][0] * rstd_h * gv[bj][0], v1 = xv[bj][1] * rstd_h * gv[bj][1];
                        u32x4e w; w.x = cvt_pk_bf16(v0[0], v0[1]); w.y = cvt_pk_bf16(v0[2], v0[3]); w.z = cvt_pk_bf16(v1[0], v1[1]); w.w = cvt_pk_bf16(v1[2], v1[3]);
                        *(u32x4e*)(rowp + bj * 32) = w; }
                }
        } else {
#pragma unroll
            for (int ai = 0; ai < 2; ++ai)
#pragma unroll
                for (int m = 0; m < 4; ++m) {
                    bf16_t* rowp = base + (size_t)(row0 + ai * HALF + m * 16) * ldo + colh;
                    const float rs_ = AFF ? rstd[trow0 + ai * HALF + m * 16] : 1.0f;
#pragma unroll
                    for (int bj = 0; bj < 2; ++bj) { f32x4 v0 = acc[ai][bj][m][0], v1 = acc[ai][bj][m][1]; if (AFF) { v0 = v0 * rs_ + cbv[bj][0]; v1 = v1 * rs_ + cbv[bj][1]; }
                        if (mode == 3) {
#pragma unroll
                            for (int e = 0; e < 4; ++e) { v0[e] = v0[e] * __builtin_amdgcn_rcpf(1.0f + __expf(-v0[e])); v1[e] = v1[e] * __builtin_amdgcn_rcpf(1.0f + __expf(-v1[e])); } }
                        u32x4e w; w.x = cvt_pk_bf16(v0[0], v0[1]); w.y = cvt_pk_bf16(v0[2], v0[3]); w.z = cvt_pk_bf16(v1[0], v1[1]); w.w = cvt_pk_bf16(v1[2], v1[3]);
                        *(u32x4e*)(rowp + bj * 32) = w; }
                }
        }
    }
};
typedef EpiProjT<false> EpiProj;
template <bool BASE_BF16, bool OUT_BF16> struct EpiRes {
    static constexpr bool PERM = true, AFTER_DRAIN = false;
    const void* base; void* out; const float* gate; int ldg;
    __device__ __forceinline__ void operator()(const f32x4 (&acc)[2][2][4][2], const Unit& u, int wr, int wc, int fr, int fq) const {
        const int col = (u.pn * 4 + wc) * 64 + 8 * fq, row0 = u.pm * BM + wr * 64 + fr;
        const float* gp = gate + (size_t)(u.pm >> 5) * ldg + col;
        f32x4 gv[2][2];
#pragma unroll
        for (int bj = 0; bj < 2; ++bj)
#pragma unroll
            for (int n = 0; n < 2; ++n) gv[bj][n] = *(const f32x4*)(gp + 32 * bj + 4 * n);
#pragma unroll
        for (int ai = 0; ai < 2; ++ai) {
            f32x4 bs[4][2][2];
#pragma unroll
            for (int m = 0; m < 4; ++m) { const size_t off = (size_t)(row0 + ai * HALF + m * 16) * 1024 + col;
#pragma unroll
                for (int bj = 0; bj < 2; ++bj) {
                    if (BASE_BF16) { const u32x4e w = *(const u32x4e*)((const bf16_t*)base + off + 32 * bj);
                        bs[m][bj][0] = (f32x4){__uint_as_float(w.x << 16), __uint_as_float(w.x & 0xffff0000u), __uint_as_float(w.y << 16), __uint_as_float(w.y & 0xffff0000u)};
                        bs[m][bj][1] = (f32x4){__uint_as_float(w.z << 16), __uint_as_float(w.z & 0xffff0000u), __uint_as_float(w.w << 16), __uint_as_float(w.w & 0xffff0000u)}; }
                    else { bs[m][bj][0] = *(const f32x4*)((const float*)base + off + 32 * bj); bs[m][bj][1] = *(const f32x4*)((const float*)base + off + 32 * bj + 4); } } }
            asm volatile("" ::: "memory");
#pragma unroll
            for (int m = 0; m < 4; ++m) { const size_t off = (size_t)(row0 + ai * HALF + m * 16) * 1024 + col;
#pragma unroll
                for (int bj = 0; bj < 2; ++bj) { const f32x4 v0 = bs[m][bj][0] + gv[bj][0] * acc[ai][bj][m][0], v1 = bs[m][bj][1] + gv[bj][1] * acc[ai][bj][m][1];
                    if (OUT_BF16) { u32x4e w; w.x = cvt_pk_bf16(v0[0], v0[1]); w.y = cvt_pk_bf16(v0[2], v0[3]); w.z = cvt_pk_bf16(v1[0], v1[1]); w.w = cvt_pk_bf16(v1[2], v1[3]); *(u32x4e*)((bf16_t*)out + off + 32 * bj) = w; }
                    else { *(f32x4*)((float*)out + off + 32 * bj) = v0; *(f32x4*)((float*)out + off + 32 * bj + 4) = v1; } } }
            asm volatile("" ::: "memory");
        }
    }
};
template <class Epi, class Sched, bool ALIGN_EPI = false, bool SP2 = false>
__device__ __forceinline__ void gemm_phase(PG8_LAS unsigned char* lds, const Gemm g, const Sched& S, const Epi& E, const int wave_) {
    int tid; { int l_; asm volatile("v_mbcnt_lo_u32_b32 %0, -1, 0\n\tv_mbcnt_hi_u32_b32 %0, -1, %0" : "=v"(l_)); tid = wave_ * 64 + l_; }
    const int wid = __builtin_amdgcn_readfirstlane(tid >> 6), lane = tid & 63, wr = wid >> 2, wc = wid & 3, fr = lane & 15, fq = lane >> 4;
    const int K = g.K, nt = K / BK;
    unsigned voffA[2], voffB[2];
#pragma unroll
    for (int i = 0; i < 2; ++i) { int R, C; stage_rc(tid * 16 + i * 8192, R, C); const int Rb = Epi::PERM ? ((R & ~31) + perm32(R & 31)) : R;
        voffA[i] = (unsigned)(R * K + C) * 2u; voffB[i] = (unsigned)(Rb * K + C) * 2u; }
    const size_t kstep = (size_t)(BK * 2);
    const size_t hstep = (size_t)HALF * K * 2;
    const size_t tstep = 2 * hstep;
    const unsigned ldsw = (unsigned)wid * 1024u;
    const int aoff = lds_byte(wr * 64 + fr, fq * 8), boff = lds_byte(wc * 32 + fr, fq * 8);
#define PG8_SA(b, h) (((b) * 2 + (h)) * HTB)
#define PG8_SB(b, h) ((4 + (b) * 2 + (h)) * HTB)
#define PG8_STAGE(bufoff, gbase, voff) do { _Pragma("unroll") for (int _i = 0; _i < 2; ++_i) \
        __builtin_amdgcn_global_load_lds((const unsigned*)((const char*)(gbase) + (voff)[_i]), (PG8_LAS unsigned*)(lds + (bufoff) + ldsw + _i * 8192), 16, 0, 0); } while (0)
#define PG8_LDA(dst, b, h) do { _Pragma("unroll") for (int m = 0; m < 4; ++m) _Pragma("unroll") for (int k = 0; k < 2; ++k) dst[m][k] = *(const PG8_LAS bf16x8*)(lds + PG8_SA(b, h) + aoff + m * 2048 + k * 1024); } while (0)
#define PG8_LDB(dst, b, h) do { _Pragma("unroll") for (int n = 0; n < 2; ++n) _Pragma("unroll") for (int k = 0; k < 2; ++k) dst[n][k] = *(const PG8_LAS bf16x8*)(lds + PG8_SB(b, h) + boff + n * 2048 + k * 1024); } while (0)
#define PG8_MMA(ai, bj, At, Bt) do { __builtin_amdgcn_s_setprio(1); _Pragma("unroll") for (int m = 0; m < 4; ++m) _Pragma("unroll") for (int n = 0; n < 2; ++n) _Pragma("unroll") for (int k = 0; k < 2; ++k) \
        acc[ai][bj][m][n] = __builtin_amdgcn_mfma_f32_16x16x32_bf16(Bt[n][k], At[m][k], acc[ai][bj][m][n], 0, 0, 0); __builtin_amdgcn_s_setprio(0); } while (0)
#define PG8_WAIT_V(n) asm volatile("s_waitcnt vmcnt(" #n ")" ::: "memory")
#define PG8_WAIT_L(n) asm volatile("s_waitcnt lgkmcnt(" #n ")" ::: "memory")
#define PG8_BAR __builtin_amdgcn_s_barrier()
#define PG8_SCHED __builtin_amdgcn_sched_barrier(0)
    Unit cur, nxt; int ui = 0;
    if (!S.next(0, cur)) return;
    f32x4 acc[2][2][4][2];
#pragma unroll
    for (int a = 0; a < 2; ++a)
#pragma unroll
        for (int b = 0; b < 2; ++b)
#pragma unroll
            for (int m = 0; m < 4; ++m)
#pragma unroll
                for (int n = 0; n < 2; ++n) acc[a][b][m][n] = (f32x4){0.f, 0.f, 0.f, 0.f};
    bf16x8 At[4][2], B0[2][2], B1[2][2];
    const char* cA = (const char*)g.A + (size_t)cur.pm * tstep; const char* cB = (const char*)g.Bt + (size_t)cur.pn * tstep + (size_t)(cur.pm >> 5) * g.bstride * 2;
    S.a_ready(cur);
    if constexpr (SP2) {
        PG8_STAGE(PG8_SB(0, 0), cB, voffB); PG8_STAGE(PG8_SB(0, 1), cB + hstep, voffB); PG8_STAGE(PG8_SA(0, 0), cA, voffA); PG8_STAGE(PG8_SA(0, 1), cA + hstep, voffA);
        if (wr == 1) PG8_BAR;
        PG8_WAIT_V(2); PG8_BAR;
        PG8_STAGE(PG8_SB(1, 0), cB + kstep, voffB); PG8_STAGE(PG8_SA(1, 0), cA + kstep, voffA); PG8_STAGE(PG8_SB(1, 1), cB + hstep + kstep, voffB);
        PG8_WAIT_V(6); PG8_BAR;
    } else {
        PG8_STAGE(PG8_SB(0, 0), cB, voffB); PG8_STAGE(PG8_SA(0, 0), cA, voffA); PG8_STAGE(PG8_SB(0, 1), cB + hstep, voffB); PG8_STAGE(PG8_SA(0, 1), cA + hstep, voffA);
        if (wr == 1) PG8_BAR;
        PG8_WAIT_V(4); PG8_BAR;
        PG8_STAGE(PG8_SB(1, 0), cB + kstep, voffB); PG8_STAGE(PG8_SA(1, 0), cA + kstep, voffA); PG8_STAGE(PG8_SB(1, 1), cB + hstep + kstep, voffB);
        PG8_WAIT_V(6); PG8_BAR;
    }
    for (;;) {
        const bool has_next = S.next(ui + 1, nxt);
        const char* nA = has_next ? (const char*)g.A + (size_t)nxt.pm * tstep : cA; const char* nB = has_next ? (const char*)g.Bt + (size_t)nxt.pn * tstep + (size_t)(nxt.pm >> 5) * g.bstride * 2 : cB;
        for (int t = 0; t < nt; t += 2) {
            const bool last = (t == nt - 2);
            const char* a1 = cA + (size_t)(t + 1) * kstep;
            const char* a2 = last ? nA : cA + (size_t)(t + 2) * kstep; const char* b2 = last ? nB : cB + (size_t)(t + 2) * kstep;
            const char* a3 = a2 + kstep; const char* b3 = b2 + kstep;
            if (last && has_next) S.a_ready(nxt);
            if constexpr (SP2) {
            PG8_LDB(B0, 0, 0); PG8_LDB(B1, 0, 1); PG8_SCHED; PG8_LDA(At, 0, 0); PG8_STAGE(PG8_SA(1, 1), a1 + hstep, voffA);
            PG8_WAIT_V(8); PG8_WAIT_L(0); PG8_BAR; PG8_MMA(0, 0, At, B0); PG8_MMA(0, 1, At, B1); PG8_BAR; PG8_SCHED;
            PG8_LDA(At, 0, 1); PG8_STAGE(PG8_SB(0, 0), b2, voffB); PG8_STAGE(PG8_SB(0, 1), b2 + hstep, voffB); PG8_STAGE(PG8_SA(0, 0), a2, voffA);
            PG8_WAIT_V(8); PG8_WAIT_L(0); PG8_BAR; PG8_MMA(1, 0, At, B0); PG8_MMA(1, 1, At, B1); PG8_BAR; PG8_SCHED;
            PG8_LDB(B0, 1, 0); PG8_LDB(B1, 1, 1); PG8_SCHED; PG8_LDA(At, 1, 0); PG8_STAGE(PG8_SA(0, 1), a2 + hstep, voffA);
            PG8_WAIT_V(8); PG8_WAIT_L(0); PG8_BAR; PG8_MMA(0, 0, At, B0); PG8_MMA(0, 1, At, B1); PG8_BAR; PG8_SCHED;
            PG8_LDA(At, 1, 1); PG8_STAGE(PG8_SB(1, 0), b3, voffB); PG8_STAGE(PG8_SB(1, 1), b3 + hstep, voffB); PG8_STAGE(PG8_SA(1, 0), a3, voffA);
            PG8_WAIT_V(8); PG8_WAIT_L(0); PG8_BAR; PG8_MMA(1, 0, At, B0); PG8_MMA(1, 1, At, B1); PG8_BAR; PG8_SCHED;
            } else {
            PG8_LDB(B0, 0, 0); PG8_SCHED; PG8_LDA(At, 0, 0); PG8_STAGE(PG8_SA(1, 1), a1 + hstep, voffA);
            PG8_WAIT_L(8); PG8_BAR; PG8_WAIT_L(0); PG8_MMA(0, 0, At, B0); PG8_BAR; PG8_SCHED;
            PG8_LDB(B1, 0, 1); PG8_STAGE(PG8_SB(0, 0), b2, voffB);
            PG8_BAR; PG8_WAIT_L(0); PG8_MMA(0, 1, At, B1); PG8_BAR;
            PG8_LDA(At, 0, 1); PG8_STAGE(PG8_SA(0, 0), a2, voffA);
            PG8_BAR; PG8_WAIT_L(0); PG8_MMA(1, 0, At, B0); PG8_BAR; PG8_SCHED;
            PG8_STAGE(PG8_SB(0, 1), b2 + hstep, voffB);
            PG8_WAIT_V(6); PG8_BAR; PG8_MMA(1, 1, At, B1); PG8_BAR;
            PG8_LDB(B0, 1, 0); PG8_SCHED; PG8_LDA(At, 1, 0); PG8_STAGE(PG8_SA(0, 1), a2 + hstep, voffA);
            PG8_WAIT_L(8); PG8_BAR; PG8_WAIT_L(0); PG8_MMA(0, 0, At, B0); PG8_BAR; PG8_SCHED;
            PG8_LDB(B1, 1, 1); PG8_STAGE(PG8_SB(1, 0), b3, voffB);
            PG8_BAR; PG8_WAIT_L(0); PG8_MMA(0, 1, At, B1); PG8_BAR;
            PG8_LDA(At, 1, 1); PG8_STAGE(PG8_SA(1, 0), a3, voffA);
            PG8_BAR; PG8_WAIT_L(0); PG8_MMA(1, 0, At, B0); PG8_BAR; PG8_SCHED;
            PG8_STAGE(PG8_SB(1, 1), b3 + hstep, voffB);
            PG8_WAIT_V(6); PG8_BAR; PG8_MMA(1, 1, At, B1); PG8_BAR;
            }
        }
        if constexpr (ALIGN_EPI) { if (wr == 0) PG8_BAR; }
        if constexpr (!Epi::AFTER_DRAIN) { E(acc, cur, wr, wc, fr, fq); S.done(cur); }
        if (!has_next) break;
#pragma unroll
        for (int a = 0; a < 2; ++a)
#pragma unroll
            for (int b = 0; b < 2; ++b)
#pragma unroll
                for (int m = 0; m < 4; ++m)
#pragma unroll
                    for (int n = 0; n < 2; ++n) acc[a][b][m][n] = (f32x4){0.f, 0.f, 0.f, 0.f};
        cur = nxt; cA = nA; cB = nB; ++ui;
        if constexpr (ALIGN_EPI) { if (wr == 1) PG8_BAR; }
    }
    PG8_WAIT_V(0);
    if constexpr (!ALIGN_EPI) { if (wr == 0) PG8_BAR; }
    PG8_BAR;
    if constexpr (Epi::AFTER_DRAIN) { E.fused(acc, cur, wr, wc, fr, fq, lds, wid, lane); S.done(cur); }
#undef PG8_SA
#undef PG8_SB
#undef PG8_STAGE
#undef PG8_LDA
#undef PG8_LDB
#undef PG8_MMA
#undef PG8_WAIT_V
#undef PG8_WAIT_L
#undef PG8_BAR
#undef PG8_SCHED
}
}
constexpr int BATCH = 8, SEQ = 8192, DM = 1024, MROWS = BATCH * SEQ;
constexpr float LOG2E = 1.4426950408889634f;
constexpr size_t MiB = 1u << 20;
constexpr size_t WS_CTL = 0, WS_MOD = 1 * MiB, WS_WINA = 2 * MiB, WS_WOUTA = 10 * MiB, WS_WKV = 12 * MiB, WS_WINB = 13 * MiB, WS_WOUTB = 17 * MiB;
constexpr size_t WS_R0 = 32 * MiB, WS_R1 = 160 * MiB, WS_R2 = 288 * MiB, WS_R3 = 416 * MiB, WS_R4 = 544 * MiB, WS_H = 672 * MiB, WS_END = 928 * MiB;
constexpr int LDS_BYTES = 147456;
constexpr int NTHREADS = 512;

#define LAS __attribute__((address_space(3)))
typedef unsigned short bf16_t;
typedef short bf16x8 __attribute__((ext_vector_type(8)));
typedef short s16x4 __attribute__((ext_vector_type(4)));
typedef float f32x4 __attribute__((ext_vector_type(4)));
typedef float f32x16 __attribute__((ext_vector_type(16)));
typedef unsigned u32x4 __attribute__((ext_vector_type(4)));
typedef unsigned u32x2 __attribute__((ext_vector_type(2)));
typedef LAS const unsigned char* lds_cptr;

__device__ __forceinline__ unsigned cvtpk(float lo, float hi) { unsigned r; asm("v_cvt_pk_bf16_f32 %0, %1, %2" : "=v"(r) : "v"(lo), "v"(hi)); return r; }
__device__ __forceinline__ float bf_lo(unsigned w) { return __uint_as_float(w << 16); }
__device__ __forceinline__ float bf_hi(unsigned w) { return __uint_as_float(w & 0xffff0000u); }
__device__ __forceinline__ float wave_sum(float v) {
#pragma unroll
    for (int o = 1; o < 64; o <<= 1) v += __shfl_xor(v, o);
    return v;
}
__device__ __forceinline__ float half_swap_max(float m) { auto rr = __builtin_amdgcn_permlane32_swap(__float_as_uint(m), __float_as_uint(m), false, false); return fmaxf(__uint_as_float(rr[0]), __uint_as_float(rr[1])); }
__device__ __forceinline__ float half_swap_sum(float m) { auto rr = __builtin_amdgcn_permlane32_swap(__float_as_uint(m), __float_as_uint(m), false, false); return __uint_as_float(rr[0]) + __uint_as_float(rr[1]); }
__device__ __forceinline__ int my_tid(int wave) { int l_; asm volatile("v_mbcnt_lo_u32_b32 %0, -1, 0\n\tv_mbcnt_hi_u32_b32 %0, -1, %0" : "=v"(l_)); return wave * 64 + l_; }
#define XB_TMO      128
#define XB_XCNT(j)  (256  + 64 * (j))
#define XB_XSUB(j)  (1280 + 64 * (j))
#define XB_XGEN(j)  (2304 + 64 * (j))
#define XB_TOP      3328
#define XB_TOPGEN   3392
#define XCD_BAR_WORDS 3456
#define XB_SPIN_CAP (1u << 23)
__device__ __forceinline__ unsigned xb_ld(unsigned* p)              { return __hip_atomic_load(p, __ATOMIC_RELAXED, __HIP_MEMORY_SCOPE_AGENT); }
__device__ __forceinline__ unsigned xb_add(unsigned* p, unsigned v) { return __hip_atomic_fetch_add(p, v, __ATOMIC_RELAXED, __HIP_MEMORY_SCOPE_AGENT); }
#define XB_SPIN(cond, bar) do { unsigned _sp = 0; while (cond) { __builtin_amdgcn_s_sleep(1); \
    if ((++_sp & 255u) == 0u) { if (xb_ld(&(bar)[XB_TMO])) break; if (_sp > XB_SPIN_CAP) { atomicAdd(&(bar)[XB_TMO], 1u); break; } } } } while (0)
__device__ __forceinline__ void grid_bar(unsigned* bar, const unsigned x, volatile LAS unsigned* st, int wave) {
    asm volatile("s_waitcnt vmcnt(0)" ::: "memory");
    __syncthreads();
    if (my_tid(wave) == 0) {
        __builtin_amdgcn_s_waitcnt(0);
        unsigned nloc = st[0], nx = st[1];
        if (nloc == 0u) {
            const unsigned G_ = gridDim.x; unsigned sum, cnt, mine, sp = 0u;
            for (;;) {
                sum = 0u; cnt = 0u; mine = 0u;
#pragma unroll
                for (unsigned jx = 0; jx < 16; ++jx) { const unsigned c_ = xb_ld(&bar[XB_XCNT(jx)]); sum += c_; cnt += (c_ > 0u) ? 1u : 0u; mine = (jx == x) ? c_ : mine; }
                if (sum == G_) break;
                __builtin_amdgcn_s_sleep(1);
                if ((++sp & 255u) == 0u) { if (xb_ld(&bar[XB_TMO])) break; if (sp > XB_SPIN_CAP) { atomicAdd(&bar[XB_TMO], 1u); break; } }
            }
            nloc = mine > 0u ? mine : 1u; nx = cnt > 0u ? cnt : 1u; st[0] = nloc; st[1] = nx;
        }
        const unsigned old = xb_add(&bar[XB_XSUB(x)], 1u);
        const unsigned gen = old / nloc;
        if (old + 1u == (gen + 1u) * nloc) {
            __builtin_amdgcn_fence(__ATOMIC_RELEASE, "agent");
            asm volatile("s_waitcnt vmcnt(0)" ::: "memory");
            const unsigned og = xb_add(&bar[XB_TOP], 1u);
            const unsigned tg = og / nx;
            if (og + 1u == (tg + 1u) * nx) xb_add(&bar[XB_TOPGEN], 1u);
            else XB_SPIN(xb_ld(&bar[XB_TOPGEN]) == tg, bar);
            __builtin_amdgcn_fence(__ATOMIC_ACQUIRE, "agent");
            xb_add(&bar[XB_XGEN(x)], 1u);
            asm volatile("s_waitcnt vmcnt(0)" ::: "memory");
        } else {
            XB_SPIN(xb_ld(&bar[XB_XGEN(x)]) == gen, bar);
            __builtin_amdgcn_fence(__ATOMIC_ACQUIRE, "agent");
            asm volatile("s_waitcnt vmcnt(0)" ::: "memory");
        }
    }
    __syncthreads();
}
__device__ __forceinline__ int crow(int r, int hi) { return (r & 3) + 8 * (r >> 2) + 4 * hi; }
__device__ __forceinline__ void glds16(const void* g, unsigned lds_base) {
    unsigned sv; asm volatile("s_mov_b32 %0, m0\n\ts_mov_b32 m0, %2\n\ts_nop 0\n\tglobal_load_lds_dwordx4 %1, off\n\ts_mov_b32 m0, %0" : "=&s"(sv) : "v"(g), "s"(lds_base) : "memory"); }
#define GLDS(g, dst) glds16((g), (unsigned)__builtin_amdgcn_readfirstlane((int)(dst)))
#define WAIT_BAR(N) asm volatile("s_waitcnt vmcnt(" #N ") lgkmcnt(0)\n\ts_barrier" ::: "memory")
#define LDS_WAIT() asm volatile("s_waitcnt lgkmcnt(0)" ::: "memory")
typedef short v4i16_t __attribute__((ext_vector_type(4)));
__device__ __forceinline__ s16x4 vtr(lds_cptr p) { return __builtin_bit_cast(s16x4, __builtin_amdgcn_ds_read_tr16_b64_v4i16((LAS v4i16_t*)p)); }
#define MFMA32(a, b, c) __builtin_amdgcn_mfma_f32_32x32x16_bf16((a), (b), (c), 0, 0, 0)

__device__ __forceinline__ void pack_p(bf16x8 (&pf)[4], const f32x16& p0, const f32x16& p1) {
    u32x4 w;
    w.x = cvtpk(p0[0], p0[1]); w.y = cvtpk(p0[2], p0[3]); w.z = cvtpk(p0[4], p0[5]); w.w = cvtpk(p0[6], p0[7]); pf[0] = __builtin_bit_cast(bf16x8, w);
    w.x = cvtpk(p0[8], p0[9]); w.y = cvtpk(p0[10], p0[11]); w.z = cvtpk(p0[12], p0[13]); w.w = cvtpk(p0[14], p0[15]); pf[1] = __builtin_bit_cast(bf16x8, w);
    w.x = cvtpk(p1[0], p1[1]); w.y = cvtpk(p1[2], p1[3]); w.z = cvtpk(p1[4], p1[5]); w.w = cvtpk(p1[6], p1[7]); pf[2] = __builtin_bit_cast(bf16x8, w);
    w.x = cvtpk(p1[8], p1[9]); w.y = cvtpk(p1[10], p1[11]); w.z = cvtpk(p1[12], p1[13]); w.w = cvtpk(p1[14], p1[15]); pf[3] = __builtin_bit_cast(bf16x8, w);
}
constexpr int ASLOT = 32768;
__device__ __forceinline__ void attnA_unit(const int wave_, LAS unsigned char* lds, unsigned lds0, const int s0, const int pre, LAS int* nextw, const LAS int* cuts, const LAS int* utab, unsigned* qheads, const int xcc, bf16x8 (&qio)[4],
                                           int b, int h, int qb, int t_lo, float smax2,
                                           const bf16_t* QA, const bf16_t* KA, const bf16_t* VA, const bf16_t* ZA, bf16_t* OA, const float* subg, float lam) {
    const int tid = my_tid(wave_);
    const int lane = tid & 63, r32 = lane & 31, hi = lane >> 5;
    const int wid = wave_, j = wid >> 2, wq = wid & 3;
    const int q0 = qb * 128, NT = (q0 + 128) / 64 - t_lo;
    const size_t rowbase = (size_t)b * SEQ;
    const int qloc = 32 * wq + r32, qpos = q0 + qloc;
    const float slope2 = exp2f(-(float)(h + 1)) * LOG2E;
    bf16x8 qf[4];
    if (pre) {
#pragma unroll
        for (int d0 = 0; d0 < 4; ++d0) qf[d0] = qio[d0];
    } else { const bf16_t* Qw = QA + (rowbase + qpos) * 1024 + (2 * h + j) * 64 + hi * 8;
#pragma unroll
      for (int d0 = 0; d0 < 4; ++d0) qf[d0] = *(const bf16x8*)(Qw + d0 * 16); }
    const int krow = 8 * wid + (lane >> 3), kch = (lane & 7) ^ ((krow >> 1) & 7);
    const bf16_t* ksrc0 = KA + ((size_t)(b * 16 + 2 * h) * SEQ + krow) * 64 + kch * 8;
    const int pva = 2 * wid, pvb = 2 * wid + 1, vch = (lane & 15) ^ (((lane >> 4) & 3) << 2);
    const bf16_t* vsrcA = VA + ((size_t)(b * 8 + h) * SEQ + 4 * pva + (lane >> 4)) * 128 + vch * 8;
    const bf16_t* vsrcB = vsrcA + 4 * 128;
    const int klane = krow * 64 + kch * 8, vlane = (4 * pva + (lane >> 4)) * 128 + vch * 8;
    const unsigned kdst = lds0 + wid * 1024, vdstA = lds0 + 16384 + pva * 1024, vdstB = lds0 + 16384 + pvb * 1024;
#define DMA_TILE(t, sl) do { const size_t ko_ = (size_t)(t) * 64 * 64, vo_ = (size_t)(t) * 64 * 128; const unsigned so_ = (unsigned)(sl) * ASLOT; \
        GLDS(ksrc0 + ko_, kdst + so_); GLDS(ksrc0 + (size_t)SEQ * 64 + ko_, kdst + 8192 + so_); GLDS(vsrcA + vo_, vdstA + so_); GLDS(vsrcB + vo_, vdstB + so_); } while (0)
    asm volatile("" ::: "memory");
    if (!pre) { DMA_TILE(t_lo, s0);
        if (NT > 1) DMA_TILE(t_lo + 1, s0 + 1); }
    if (NT > 2) DMA_TILE(t_lo + 2, (s0 + 2) & 3);
    f32x16 bias0;
#pragma unroll
    for (int r = 0; r < 16; ++r) bias0[r] = slope2 * (float)(crow(r, hi) - qloc);
    const float s32 = 32.f * slope2;
    float l = 0.f;
    f32x16 o[4];
#pragma unroll
    for (int db = 0; db < 4; ++db)
#pragma unroll
        for (int r = 0; r < 16; ++r) o[db][r] = 0.f;
    const int kofs = j * 8192 + r32 * 128;
    const int kx0 = (hi ^ ((r32 >> 1) & 7)) * 16;
    const int vx0 = 256 * (4 * hi + ((lane & 15) >> 2)) + 16 * (4 * ((lane >> 2) & 3) + 2 * ((lane >> 4) & 1) + ((lane >> 1) & 1)) + 8 * (lane & 1);
    const int qfirst = q0 + 32 * wq, qlast = qfirst + 31;
    const int NTw = (64 * (t_lo + NT - 1) <= qlast) ? NT : NT - 1;
    f32x16 p0, p1;
#define SB0() __builtin_amdgcn_sched_barrier(0)
#define PINV(x) asm volatile("" : "+v"(x))
#define KLD(kf, sl, d0) do { const lds_cptr kb_ = (lds_cptr)lds + (sl) * ASLOT + kofs + (kx0 ^ (32 * (d0))); kf[0] = *(const LAS bf16x8*)(kb_); kf[1] = *(const LAS bf16x8*)(kb_ + 4096); } while (0)
    struct VF1 { s16x4 lo, hh; };
#define VLD1(vf, sl, g_) do { const lds_cptr vb_ = (lds_cptr)lds + (sl) * ASLOT + 16384 + (vx0 ^ (64 * ((g_) >> 2))) + ((g_) & 3) * 4096; vf.lo = vtr(vb_); vf.hh = vtr(vb_ + 2048); } while (0)
#define VF8(vf) ((bf16x8){vf.lo[0], vf.lo[1], vf.lo[2], vf.lo[3], vf.hh[0], vf.hh[1], vf.hh[2], vf.hh[3]})
#define QK8(sl) do { bf16x8 ka[2], kb2[2], kc[2], kd[2]; \
        KLD(ka, sl, 0); KLD(kb2, sl, 1); KLD(kc, sl, 2); KLD(kd, sl, 3); SB0(); \
        p0 = MFMA32(ka[0], qf[0], bias0); p1 = MFMA32(ka[1], qf[0], bias0); p0 = MFMA32(kb2[0], qf[1], p0); p1 = MFMA32(kb2[1], qf[1], p1); \
        p0 = MFMA32(kc[0], qf[2], p0); p1 = MFMA32(kc[1], qf[2], p1); p0 = MFMA32(kd[0], qf[3], p0); p1 = MFMA32(kd[1], qf[3], p1); SB0(); } while (0)
#define KLOADS(sl) bf16x8 ka[2], kb2[2], kc[2], kd[2]; KLD(ka, sl, 0); KLD(kb2, sl, 1); KLD(kc, sl, 2); KLD(kd, sl, 3); SB0()
#define QKMMA() do { p0 = MFMA32(ka[0], qf[0], bias0); p1 = MFMA32(ka[1], qf[0], bias0); p0 = MFMA32(kb2[0], qf[1], p0); p1 = MFMA32(kb2[1], qf[1], p1); \
        p0 = MFMA32(kc[0], qf[2], p0); p1 = MFMA32(kc[1], qf[2], p1); p0 = MFMA32(kd[0], qf[3], p0); p1 = MFMA32(kd[1], qf[3], p1); SB0(); } while (0)
#define MASK(t) do { if (64 * (t) + 63 > qfirst) { const int qh = qpos - 64 * (t) - 4 * hi; \
            _Pragma("unroll") for (int r = 0; r < 16; ++r) { const int cr = (r & 3) + 8 * (r >> 2); if (cr > qh) p0[r] = -INFINITY; if (cr + 32 > qh) p1[r] = -INFINITY; } SB0(); } } while (0)
    u32x4 pc0, pc1, pc2, pc3;
    if (NT > 2) { WAIT_BAR(4); } else { WAIT_BAR(0); }
    int pend = 1 << 20; if (tid == 0) pend = (int)atomicAdd(qheads + 64 * b, 1u);
    QK8(s0); MASK(t_lo);
    { const float c0 = slope2 * (float)(64 * t_lo - q0) - smax2, c1 = c0 + s32; float rs = 0.f;
#pragma unroll
      for (int r = 0; r < 16; ++r) { p0[r] = __builtin_amdgcn_exp2f(p0[r] + c0); p1[r] = __builtin_amdgcn_exp2f(p1[r] + c1); rs += p0[r] + p1[r]; }
      l += rs;
      pc0 = (u32x4){cvtpk(p0[0], p0[1]), cvtpk(p0[2], p0[3]), cvtpk(p0[4], p0[5]), cvtpk(p0[6], p0[7])};
      pc1 = (u32x4){cvtpk(p0[8], p0[9]), cvtpk(p0[10], p0[11]), cvtpk(p0[12], p0[13]), cvtpk(p0[14], p0[15])};
      pc2 = (u32x4){cvtpk(p1[0], p1[1]), cvtpk(p1[2], p1[3]), cvtpk(p1[4], p1[5]), cvtpk(p1[6], p1[7])};
      pc3 = (u32x4){cvtpk(p1[8], p1[9]), cvtpk(p1[10], p1[11]), cvtpk(p1[12], p1[13]), cvtpk(p1[14], p1[15])}; SB0(); }
    for (int i = 0; i + 1 < NTw; ++i) {
        const int t = t_lo + i;
        if (i + 2 < NT) { WAIT_BAR(4); } else { WAIT_BAR(0); }
        {
            const int sv = (i + s0) & 3;
            KLOADS((i + 1 + s0) & 3);
            VF1 vcur, vn1; VLD1(vcur, sv, 0); VLD1(vn1, sv, 1); SB0();
            if (i + 3 < NT) DMA_TILE(t + 3, (i + 3 + s0) & 3);
            const bf16x8 q0_ = __builtin_bit_cast(bf16x8, pc0), q1_ = __builtin_bit_cast(bf16x8, pc1), q2_ = __builtin_bit_cast(bf16x8, pc2), q3_ = __builtin_bit_cast(bf16x8, pc3);
            SB0();
            QKMMA(); MASK(t + 1);
            const float c0 = slope2 * (float)(64 * (t + 1) - q0) - smax2, c1 = c0 + s32; float rs = 0.f;
            u32x4 n0, n1, n2, n3;
#pragma unroll
            for (int g = 0; g < 16; ++g) {
                VF1 vn2; if (g < 14) VLD1(vn2, sv, g + 2);
                const bf16x8 pk_ = (g & 3) == 0 ? q0_ : (g & 3) == 1 ? q1_ : (g & 3) == 2 ? q2_ : q3_;
                o[g >> 2] = MFMA32(VF8(vcur), pk_, o[g >> 2]);
                p0[g] = __builtin_amdgcn_exp2f(p0[g] + c0); p1[g] = __builtin_amdgcn_exp2f(p1[g] + c1); rs += p0[g] + p1[g];
                PINV(p0[g]); PINV(p1[g]); PINV(rs);
                if (g & 1) { const unsigned wa = cvtpk(p0[g - 1], p0[g]), wb = cvtpk(p1[g - 1], p1[g]); const int k = g >> 1;
                    if (k < 4) { n0[k & 3] = wa; n2[k & 3] = wb; } else { n1[k & 3] = wa; n3[k & 3] = wb; } }
                SB0();
                vcur = vn1; if (g < 14) vn1 = vn2;
            }
            l += rs;
            pc0 = n0; pc1 = n1; pc2 = n2; pc3 = n3;
        }
    }
    {
        const int i = NTw - 1;
        if (i + 2 < NT) { WAIT_BAR(4); } else { WAIT_BAR(0); }
        if (i + 3 < NT) DMA_TILE(t_lo + i + 3, (i + 3 + s0) & 3);
        const int sv = (i + s0) & 3;
        const bf16x8 q0_ = __builtin_bit_cast(bf16x8, pc0), q1_ = __builtin_bit_cast(bf16x8, pc1), q2_ = __builtin_bit_cast(bf16x8, pc2), q3_ = __builtin_bit_cast(bf16x8, pc3);
        VF1 vcur; VLD1(vcur, sv, 0);
#pragma unroll
        for (int g = 0; g < 16; ++g) {
            VF1 vnx; if (g < 15) VLD1(vnx, sv, g + 1);
            const bf16x8 pk_ = (g & 3) == 0 ? q0_ : (g & 3) == 1 ? q1_ : (g & 3) == 2 ? q2_ : q3_;
            o[g >> 2] = MFMA32(VF8(vcur), pk_, o[g >> 2]);
            SB0();
            if (g < 15) vcur = vnx;
        }
    }
    if (NTw < NT) { WAIT_BAR(0); }
#undef KLD
#undef VLD1
#undef VF8
#undef QK8
#undef KLOADS
#undef QKMMA
#undef MASK
#undef PINV
#undef DMA_TILE
    l = half_swap_sum(l);
    const float rl = 1.0f / l;
    if (my_tid(wave_) == 0) {
        int d_ = -1;
        if (pend < 512) d_ = (b << 16) | utab[pend];
        else for (int qi_ = ((b - xcc) & 7) + 1; qi_ < 8; ++qi_) { const int bq_ = (xcc + qi_) & 7; const int ix_ = (int)atomicAdd(qheads + 64 * bq_, 1u); if (ix_ < 512) { d_ = (bq_ << 16) | utab[ix_]; break; } }
        *nextw = d_;
    }
    WAIT_BAR(0);
    const int lane2 = my_tid(wave_) & 63, hi2 = lane2 >> 5;
    {
        const int nd = *nextw;
        if (nd >= 0) {
            const int nb = nd >> 16, nh = (nd >> 6) & 7, nqb = nd & 63, ndd = nqb * 128 - cuts[nh], ntl = ndd > 0 ? ndd >> 6 : 0, nNT = 2 * nqb + 2 - ntl;
            const bf16_t* nk = KA + (size_t)(nb * 16 + 2 * nh) * SEQ * 64 + klane + (size_t)ntl * 64 * 64;
            const bf16_t* nv = VA + (size_t)(nb * 8 + nh) * SEQ * 128 + vlane + (size_t)ntl * 64 * 128;
            const unsigned so_ = (unsigned)(s0 ^ 2) * ASLOT;
            GLDS(nk, kdst + so_); GLDS(nk + (size_t)SEQ * 64, kdst + 8192 + so_); GLDS(nv, vdstA + so_); GLDS(nv + 4 * 128, vdstB + so_);
            if (nNT > 1) { GLDS(nk + 64 * 64, kdst + so_ + ASLOT); GLDS(nk + (size_t)SEQ * 64 + 64 * 64, kdst + 8192 + so_ + ASLOT); GLDS(nv + 64 * 128, vdstA + so_ + ASLOT); GLDS(nv + 64 * 128 + 4 * 128, vdstB + so_ + ASLOT); }
            const bf16_t* Qn = QA + ((size_t)nb * SEQ + nqb * 128 + 32 * wq + (lane2 & 31)) * 1024 + (2 * nh + j) * 64 + hi2 * 8;
#pragma unroll
            for (int d0 = 0; d0 < 4; ++d0) qio[d0] = *(const bf16x8*)(Qn + d0 * 16);
        }
    }
    LAS float* xch = (LAS float*)(lds + s0 * ASLOT) + wq * 4096 + lane2;
    if (j == 1) {
#pragma unroll
        for (int db = 0; db < 4; ++db)
#pragma unroll
            for (int r = 0; r < 16; ++r) xch[(db * 16 + r) * 64] = o[db][r] * rl;
    }
    WAIT_BAR(0);
    if (j == 0) {
        float ss = 0.f;
#pragma unroll
        for (int db = 0; db < 4; ++db) {
            SB0();
#pragma unroll
            for (int r = 0; r < 16; ++r) { const float v = o[db][r] * rl - lam * xch[(db * 16 + r) * 64]; o[db][r] = v; ss += v * v; }
        }
        ss = half_swap_sum(ss);
        const float rstd = rsqrtf(ss * (1.0f / 128.0f) + 1e-6f) * 0.8f;
        const size_t rowoff = ((size_t)b * SEQ + q0 + 32 * wq + (lane2 & 31)) * 1024 + h * 128;
#pragma unroll
        for (int db = 0; db < 4; ++db) {
            SB0();
#pragma unroll
            for (int rg = 0; rg < 4; ++rg) {
                const int d = 32 * db + 8 * rg + 4 * hi2;
                const f32x4 g = *(const f32x4*)(subg + d);
                const u32x2 zz = *(const u32x2*)(ZA + rowoff + d);
                const float v0 = o[db][4 * rg + 0] * rstd * g[0] * bf_lo(zz.x), v1 = o[db][4 * rg + 1] * rstd * g[1] * bf_hi(zz.x);
                const float v2 = o[db][4 * rg + 2] * rstd * g[2] * bf_lo(zz.y), v3 = o[db][4 * rg + 3] * rstd * g[3] * bf_hi(zz.y);
                u32x2 w; w.x = cvtpk(v0, v1); w.y = cvtpk(v2, v3);
                *(u32x2*)(OA + rowoff + d) = w;
            }
        }
    }
    WAIT_BAR(0);
}

__device__ __forceinline__ void attnB_stage(const int wave_, const int lane, unsigned bufaddr, int b, int kvh, int nb, const bf16_t* KVS) {
    const int krow = 8 * wave_ + (lane >> 3), kch = (lane & 7) ^ ((krow >> 1) & 7), vch = (lane & 7) ^ (((krow >> 1) & 1) << 2);
    const long row0 = (long)b * SEQ + 128L * (nb - 1) + krow;
    const bf16_t* ksrc = KVS + row0 * 256 + kvh * 64 + kch * 8;
    const bf16_t* vsrc = KVS + row0 * 256 + 128 + kvh * 64 + vch * 8;
    for (int bt = (nb == 0 ? 2 : 0); bt < 4; ++bt) { GLDS(ksrc + (size_t)bt * 64 * 256, bufaddr + bt * 16384 + wave_ * 1024); GLDS(vsrc + (size_t)bt * 64 * 256, bufaddr + bt * 16384 + 8192 + wave_ * 1024); }
}
__device__ __forceinline__ void attnB_unit(const int wave_, LAS unsigned char* buf, int b, int kvh, int nb, float smax2,
                                           const bf16_t* QB, const bf16_t* ZB, bf16_t* OB, const float* sinks) {
    const int tid = my_tid(wave_);
    const int lane = tid & 63, r32 = lane & 31, hi = lane >> 5;
    const int hq = kvh * 8 + wave_;
    const size_t rowbase = (size_t)b * SEQ;
    const float slope2 = exp2f(-0.5f * (float)(hq + 1)) * LOG2E, sink2 = sinks[hq] * LOG2E;
    const float ref = fmaxf(smax2, sink2), psink = __builtin_amdgcn_exp2f(sink2 - ref);
    const int bt0 = nb == 0 ? 2 : 0;
    const int kx0 = r32 * 128 + (hi ^ ((r32 >> 1) & 7)) * 16;
    const int rq = (lane & 15) >> 2;
    const int vx0 = 8192 + 128 * (4 * hi + rq) + 64 * (rq >> 1) + 32 * ((lane >> 4) & 1) + 8 * (lane & 3);
    const int qh = r32 - 4 * hi;
    f32x16 biasB;
#pragma unroll
    for (int r = 0; r < 16; ++r) biasB[r] = slope2 * (float)((r & 3) + 8 * (r >> 2));
    bf16x8 qf[4], qn[4];
    { const bf16_t* Qp = QB + (rowbase + nb * 128 + r32) * 1024 + hq * 64 + hi * 8;
#pragma unroll
      for (int d0 = 0; d0 < 4; ++d0) qf[d0] = *(const bf16x8*)(Qp + d0 * 16); }
    for (int rb = 0; rb < 4; ++rb) {
        const size_t rowoff = (rowbase + nb * 128 + 32 * rb + r32) * 1024 + hq * 64;
        if (rb < 3) {
#pragma unroll
            for (int d0 = 0; d0 < 4; ++d0) qn[d0] = *(const bf16x8*)(QB + rowoff + 32 * 1024 + d0 * 16 + hi * 8);
        }
        u32x2 zz[2][4];
#pragma unroll
        for (int db = 0; db < 2; ++db)
#pragma unroll
            for (int rg = 0; rg < 4; ++rg) zz[db][rg] = *(const u32x2*)(ZB + rowoff + 32 * db + 8 * rg + 4 * hi);
        float l = hi == 0 ? psink : 0.0f;
        f32x16 o[2];
#pragma unroll
        for (int db = 0; db < 2; ++db)
#pragma unroll
            for (int r = 0; r < 16; ++r) o[db][r] = 0.f;
        for (int tt = 0; tt < 3; ++tt) {
            const int bt = (rb >> 1) + tt;
            if (bt < bt0) continue;
            const lds_cptr tb = (lds_cptr)buf + bt * 16384;
            f32x16 p0, p1;
            { bf16x8 ka[2], kb2[2], kc[2], kd[2];
              ka[0] = *(const LAS bf16x8*)(tb + kx0); ka[1] = *(const LAS bf16x8*)(tb + kx0 + 4096);
              kb2[0] = *(const LAS bf16x8*)(tb + (kx0 ^ 32)); kb2[1] = *(const LAS bf16x8*)(tb + (kx0 ^ 32) + 4096);
              kc[0] = *(const LAS bf16x8*)(tb + (kx0 ^ 64)); kc[1] = *(const LAS bf16x8*)(tb + (kx0 ^ 64) + 4096);
              kd[0] = *(const LAS bf16x8*)(tb + (kx0 ^ 96)); kd[1] = *(const LAS bf16x8*)(tb + (kx0 ^ 96) + 4096);
              __builtin_amdgcn_sched_barrier(0);
              p0 = MFMA32(ka[0], qf[0], biasB); p1 = MFMA32(ka[1], qf[0], biasB); p0 = MFMA32(kb2[0], qf[1], p0); p1 = MFMA32(kb2[1], qf[1], p1);
              p0 = MFMA32(kc[0], qf[2], p0); p1 = MFMA32(kc[1], qf[2], p1); p0 = MFMA32(kd[0], qf[3], p0); p1 = MFMA32(kd[1], qf[3], p1);
              __builtin_amdgcn_sched_barrier(0); }
            s16x4 lo_, hh_, lo1_, hh1_;
            lo_ = vtr(tb + vx0); hh_ = vtr(tb + vx0 + 1024); lo1_ = vtr(tb + vx0 + 2048); hh1_ = vtr(tb + vx0 + 2048 + 1024);
            __builtin_amdgcn_sched_barrier(0);
            const int D0 = 128 + 32 * rb - 64 * bt;
            const float c0 = -slope2 * (float)(D0 + qh) - ref, c1 = c0 + 32.f * slope2;
            float rs = 0.f;
#pragma unroll
            for (int r = 0; r < 16; ++r) { p0[r] = __builtin_amdgcn_exp2f(p0[r] + c0); p1[r] = __builtin_amdgcn_exp2f(p1[r] + c1); }
#define MASKH(P, Dn) do { if ((Dn) == 128) { _Pragma("unroll") for (int r = 0; r < 16; ++r) { const int cr = (r & 3) + 8 * (r >> 2); if (!(cr > qh)) P[r] = 0.f; } } \
                else if ((Dn) == 0) { _Pragma("unroll") for (int r = 0; r < 16; ++r) { const int cr = (r & 3) + 8 * (r >> 2); if (cr > qh) P[r] = 0.f; } } \
                else if ((Dn) < 0 || (Dn) > 128) { _Pragma("unroll") for (int r = 0; r < 16; ++r) P[r] = 0.f; } } while (0)
            MASKH(p0, D0); MASKH(p1, D0 - 32);
#undef MASKH
#pragma unroll
            for (int r = 0; r < 16; ++r) rs += p0[r] + p1[r];
            l += rs;
            bf16x8 pf[4]; pack_p(pf, p0, p1);
            __builtin_amdgcn_sched_barrier(0);
            {
                s16x4 lo2_, hh2_;
#pragma unroll
                for (int g = 0; g < 8; ++g) {
                    if (g < 6) { const int g2 = g + 2; lo2_ = vtr(tb + (vx0 ^ (64 * (g2 >> 2))) + (g2 & 3) * 2048); hh2_ = vtr(tb + (vx0 ^ (64 * (g2 >> 2))) + (g2 & 3) * 2048 + 1024); }
                    const bf16x8 vf = (bf16x8){lo_[0], lo_[1], lo_[2], lo_[3], hh_[0], hh_[1], hh_[2], hh_[3]};
                    o[g >> 2] = MFMA32(vf, pf[g & 3], o[g >> 2]);
                    __builtin_amdgcn_sched_barrier(0);
                    lo_ = lo1_; hh_ = hh1_; if (g < 6) { lo1_ = lo2_; hh1_ = hh2_; }
                }
            }
        }
        l = half_swap_sum(l);
        const float rl = 1.0f / l;
#pragma unroll
        for (int db = 0; db < 2; ++db)
#pragma unroll
            for (int rg = 0; rg < 4; ++rg) {
                const int d = 32 * db + 8 * rg + 4 * hi;
                const u32x2 z_ = zz[db][rg];
                const float v0 = o[db][4 * rg + 0] * rl * bf_lo(z_.x), v1 = o[db][4 * rg + 1] * rl * bf_hi(z_.x);
                const float v2 = o[db][4 * rg + 2] * rl * bf_lo(z_.y), v3 = o[db][4 * rg + 3] * rl * bf_hi(z_.y);
                u32x2 w; w.x = cvtpk(v0, v1); w.y = cvtpk(v2, v3);
                *(u32x2*)(OB + rowoff + d) = w;
            }
        if (rb < 3) {
#pragma unroll
            for (int d0 = 0; d0 < 4; ++d0) qf[d0] = qn[d0];
        }
    }
}

__device__ __forceinline__ int permrow(int a) { const int r = a & 255; return (a & ~255) + ((r >> 5) & 1) * 128 + (r >> 6) * 32 + (r & 31); }
__device__ __forceinline__ void p0_transpose_item(const float* W, int K, int N, bf16_t* WT, LAS float* scr, int item, int lane, const float* kgain = nullptr, const float* kscale = nullptr) {
    const int nblk = N / 32, kb = item / nblk, nb = item - kb * nblk, k0 = 64 * kb, n0 = 32 * nb;
#pragma unroll 8
    for (int i = 0; i < 32; ++i) { const int kk = 2 * i + (lane >> 5); scr[kk * 33 + (lane & 31)] = W[(size_t)(k0 + kk) * N + n0 + (lane & 31)]; }
    LDS_WAIT();
    const int c = lane & 7;
    const int prow0 = permrow(n0);
#pragma unroll
    for (int jj = 0; jj < 4; ++jj) { const int n = (lane >> 3) + 8 * jj; const LAS float* s = scr + (8 * c) * 33 + n;
        f32x4 m0 = {1.f, 1.f, 1.f, 1.f}, m1 = {1.f, 1.f, 1.f, 1.f};
        if (kgain) { m0 = *(const f32x4*)(kgain + k0 + 8 * c) * (*(const f32x4*)(kscale + k0 + 8 * c) + 1.0f); m1 = *(const f32x4*)(kgain + k0 + 8 * c + 4) * (*(const f32x4*)(kscale + k0 + 8 * c + 4) + 1.0f); }
        u32x4 o; o.x = cvtpk(s[0 * 33] * m0[0], s[1 * 33] * m0[1]); o.y = cvtpk(s[2 * 33] * m0[2], s[3 * 33] * m0[3]); o.z = cvtpk(s[4 * 33] * m1[0], s[5 * 33] * m1[1]); o.w = cvtpk(s[6 * 33] * m1[2], s[7 * 33] * m1[3]);
        *(u32x4*)(WT + (size_t)(prow0 + n) * K + k0 + 8 * c) = o; }
    LDS_WAIT();
}
template <bool TWO, bool IN_BF16> __device__ __forceinline__ void norm_chunk(const void* Xv, int chunk, int lane,
        const float* g1, const float* sh1, const float* sc1, bf16_t* out1, const float* g2, const float* sh2, const float* sc2, bf16_t* out2, float* rstd_out = nullptr) {
    f32x4 A1[4], S1[4], A2[4], S2[4];
#pragma unroll
    for (int jj = 0; jj < 4; ++jj) { const int col = 4 * lane + 256 * jj;
        A1[jj] = *(const f32x4*)(g1 + col) * (*(const f32x4*)(sc1 + col) + 1.0f); S1[jj] = *(const f32x4*)(sh1 + col);
        if (TWO) { A2[jj] = *(const f32x4*)(g2 + col) * (*(const f32x4*)(sc2 + col) + 1.0f); S2[jj] = *(const f32x4*)(sh2 + col); } }
    for (int rr = 0; rr < 32; ++rr) {
        const size_t row = (size_t)chunk * 32 + rr;
        f32x4 v[4]; float ss = 0.f;
#pragma unroll
        for (int jj = 0; jj < 4; ++jj) {
            if (IN_BF16) { const u32x2 w = *(const u32x2*)((const bf16_t*)Xv + row * 1024 + 4 * lane + 256 * jj); v[jj] = (f32x4){bf_lo(w.x), bf_hi(w.x), bf_lo(w.y), bf_hi(w.y)}; }
            else v[jj] = *(const f32x4*)((const float*)Xv + row * 1024 + 4 * lane + 256 * jj);
            ss += (v[jj][0] * v[jj][0] + v[jj][1] * v[jj][1]) + (v[jj][2] * v[jj][2] + v[jj][3] * v[jj][3]); }
        const float rstd = rsqrtf(wave_sum(ss) * (1.0f / 1024.0f) + 1e-6f);
        if (rstd_out && lane == 0) rstd_out[row] = rstd;
#pragma unroll
        for (int jj = 0; jj < 4; ++jj) {
            const f32x4 xn = v[jj] * rstd;
            if (out1) { const f32x4 u = xn * A1[jj] + S1[jj]; u32x2 w; w.x = cvtpk(u[0], u[1]); w.y = cvtpk(u[2], u[3]); *(u32x2*)(out1 + row * 1024 + 4 * lane + 256 * jj) = w; }
            if (TWO) { const f32x4 u = xn * A2[jj] + S2[jj]; u32x2 w; w.x = cvtpk(u[0], u[1]); w.y = cvtpk(u[2], u[3]); *(u32x2*)(out2 + row * 1024 + 4 * lane + 256 * jj) = w; }
        }
    }
}

struct RowOrder {
    int nM, nN, G, c;
    __device__ void init(int M, int N, int G_, int c_) { nM = M / 256; nN = N / 256; G = G_; c = c_; }
    __device__ bool next(int i, pg8::Unit& u) const { const int pm = c + (i / nN) * G; if (pm >= nM) return false; u.pm = pm; u.pn = i % nN; return true; }
    __device__ __forceinline__ void a_ready(const pg8::Unit&) const {}
    __device__ __forceinline__ void done(const pg8::Unit&) const {}
};
struct Params { const float* in[26]; float* out; unsigned char* ws; int ph_lo, ph_hi; };

__global__ void __launch_bounds__(NTHREADS) yoco_fwd(Params P) {
    extern __shared__ __attribute__((aligned(16))) unsigned char lds_raw[];
    LAS unsigned char* lds = (LAS unsigned char*)lds_raw;
    const unsigned lds0 = (unsigned)(uintptr_t)lds_raw;
    LAS unsigned char* ring = lds + 16384; const unsigned ring0 = lds0 + 16384u;
    cg::grid_group grid = cg::this_grid();
    const int wave = __builtin_amdgcn_readfirstlane(threadIdx.x >> 6);
    const int G = gridDim.x, bx = blockIdx.x;
    const int vcu = (G % 8 == 0) ? (bx % 8) * (G / 8) + bx / 8 : bx;
    const int gw = vcu * 8 + wave, NGW = G * 8;
    unsigned char* ws = P.ws;
    const float* x = P.in[0];
    float* modA = (float*)(ws + WS_MOD); float* modKV = modA + 8 * 3072; float* modB = modKV + 8 * 2048;
    float* ctlf = (float*)(ws + WS_CTL);
    bf16_t* WinA = (bf16_t*)(ws + WS_WINA); bf16_t* WoutA = (bf16_t*)(ws + WS_WOUTA); bf16_t* Wkv = (bf16_t*)(ws + WS_WKV); bf16_t* WinB = (bf16_t*)(ws + WS_WINB); bf16_t* WoutB = (bf16_t*)(ws + WS_WOUTB);
    bf16_t* R0 = (bf16_t*)(ws + WS_R0); bf16_t* R1 = (bf16_t*)(ws + WS_R1); bf16_t* R2 = (bf16_t*)(ws + WS_R2); bf16_t* R3 = (bf16_t*)(ws + WS_R3); bf16_t* R4 = (bf16_t*)(ws + WS_R4);
    float* H = (float*)(ws + WS_H);
    const int lo = P.ph_lo, hi_ = P.ph_hi;
#ifndef REP_MASK
#define REP_MASK 0
#endif
#define NREP(k) ((((REP_MASK) >> (k)) & 1) + 1)
#ifndef PH_MASK
#define PH_MASK 0x1ff
#endif
#define IN(k) (((PH_MASK >> (k)) & 1) && lo <= (k) && (k) < hi_)
    unsigned* const xbar = (unsigned*)ctlf + 4096;
    const unsigned xcc_id = (unsigned)__builtin_amdgcn_s_getreg((3 << 11) | 20) & 0xFu;
    volatile LAS unsigned* const xst = (volatile LAS unsigned*)(lds + 8192);
#define GBAR() grid_bar(xbar, xcc_id, xst, wave)
#define SEAM(k) do { if (IN(k) && IN((k) + 1)) { if ((k) == 0) { grid.sync(); if (my_tid(wave) == 0) { xst[0] = 0u; xst[1] = 0u; (void)xb_add(&xbar[XB_XCNT(xcc_id)], 1u); } } else GBAR(); } } while (0)

    if (IN(0)) {
        const int tid = my_tid(wave), lane = tid & 63;
        LAS float* sc = (LAS float*)lds;
        LAS float* red = (LAS float*)(lds + 32768);
        const float* c = P.in[1];
        for (int i = tid; i < 8192; i += NTHREADS) { const int bb = i >> 10, k = i & 1023; const float v = c[i]; sc[k * 8 + bb] = v / (1.0f + __expf(-v)); }
        __syncthreads();
        for (int cgp = bx; cgp < 256; cgp += G) {
            const int n0 = cgp * 32;
            const float* W; const float* bias; int N, nloc; float* dst;
            if (n0 < 3072) { W = P.in[3]; bias = P.in[4]; N = 3072; nloc = n0; dst = modA; }
            else if (n0 < 5120) { W = P.in[15]; bias = P.in[16]; N = 2048; nloc = n0 - 3072; dst = modKV; }
            else { W = P.in[20]; bias = P.in[21]; N = 3072; nloc = n0 - 5120; dst = modB; }
            const int col = tid & 31, ks = tid >> 5;
            f32x4 a0 = {0.f, 0.f, 0.f, 0.f}, a1 = {0.f, 0.f, 0.f, 0.f};
#pragma unroll 8
            for (int kk = 0; kk < 64; ++kk) { const int k = ks * 64 + kk; const float w = W[(size_t)k * N + nloc + col];
                const f32x4 s0 = *(const LAS f32x4*)(sc + k * 8), s1 = *(const LAS f32x4*)(sc + k * 8 + 4); a0 += s0 * w; a1 += s1 * w; }
#pragma unroll
            for (int e = 0; e < 4; ++e) { red[(ks * 8 + e) * 32 + col] = a0[e]; red[(ks * 8 + 4 + e) * 32 + col] = a1[e]; }
            __syncthreads();
            if (tid < 256) { const int bb = tid >> 5, cc = tid & 31; float s = bias[nloc + cc];
#pragma unroll
                for (int k2 = 0; k2 < 16; ++k2) s += red[(k2 * 8 + bb) * 32 + cc];
                dst[(size_t)bb * N + nloc + cc] = s; }
            __syncthreads();
        }
        if (bx == 0 && wave == 0) {
            float a = P.in[8][lane] * P.in[9][lane], bq = P.in[10][lane] * P.in[11][lane];
            a = wave_sum(a); bq = wave_sum(bq);
            if (lane == 0) ctlf[0] = __expf(a) - __expf(bq) + 0.2f;
            const float gq = P.in[6][lane], gk = P.in[7][lane];
            ctlf[64 + lane] = gq; ctlf[128 + lane] = gk;
            float mq = fabsf(gq), mk = fabsf(gk);
#pragma unroll
            for (int o_ = 1; o_ < 64; o_ <<= 1) { mq = fmaxf(mq, __shfl_xor(mq, o_)); mk = fmaxf(mk, __shfl_xor(mk, o_)); }
            const float smax2 = pg8::QK_C2 * 64.0f * mq * mk * 1.02f;
            if (lane == 0) ctlf[1] = smax2;
            { float mqb = fabsf(P.in[23][lane]), mkb = fabsf(P.in[18][lane]);
#pragma unroll
              for (int o_ = 1; o_ < 64; o_ <<= 1) { mqb = fmaxf(mqb, __shfl_xor(mqb, o_)); mkb = fmaxf(mkb, __shfl_xor(mkb, o_)); }
              if (lane == 0) ctlf[2] = pg8::QK_C2 * 64.0f * mqb * mkb * 1.02f; }
            if (lane < 8) { const float sl2 = exp2f(-(float)(lane + 1)) * LOG2E; const float cf = (2.0f * smax2 + 152.0f) / sl2;
                const int ci = cf > 1.0e6f ? 1000000 : (int)cf + 1; ((int*)ctlf)[16 + lane] = ci; ((LAS int*)(lds + 131072))[lane] = ci;
                ((unsigned*)ctlf)[256 + 64 * lane] = 0u; ((unsigned*)ctlf)[256 + 512 + 64 * lane] = 0u; }
        }
        __syncthreads();
        if (bx == 0) { for (int i_ = tid; i_ < XCD_BAR_WORDS; i_ += NTHREADS) ((unsigned*)ctlf)[4096 + i_] = 0u; }
        if (bx == 0) {
            LAS int* cuts = (LAS int*)(lds + 131072); LAS int* wk = cuts + 64;
            { const int hh = tid >> 6, qq = tid & 63, dd = qq * 128 - cuts[hh]; wk[tid] = 2 * qq + 2 - (dd > 0 ? dd >> 6 : 0); }
            __syncthreads();
            { const int mine = wk[tid]; int rank = 0;
              for (int k2 = 0; k2 < 512; ++k2) { const int wo = wk[k2]; rank += (wo > mine || (wo == mine && k2 < tid)) ? 1 : 0; }
              ((int*)ctlf)[2048 + rank] = tid; }
        }
        __syncthreads();
        LAS float* scr = (LAS float*)(lds + wave * 16384);
        constexpr int I_A = 16 * 128, I_OA = 16 * 32, I_KV = 16 * 8, I_B = 16 * 64, I_OB = 16 * 32;
        for (int it = gw; it < I_A + I_OA + I_KV + I_B + I_OB; it += NGW) {
            int r = it;
            if (r < I_A) { p0_transpose_item(P.in[5], 1024, 4096, WinA, scr, r, lane); continue; } r -= I_A;
            if (r < I_OA) { p0_transpose_item(P.in[13], 1024, 1024, WoutA, scr, r, lane); continue; } r -= I_OA;
            if (r < I_KV) { p0_transpose_item(P.in[17], 1024, 256, Wkv, scr, r, lane); continue; } r -= I_KV;
            if (r < I_B) { p0_transpose_item(P.in[22], 1024, 2048, WinB, scr, r, lane); continue; } r -= I_B;
            p0_transpose_item(P.in[25], 1024, 1024, WoutB, scr, r, lane);
        }
    }
    SEAM(0);
    bf16_t* const WkvB = (bf16_t*)(ws + 20 * MiB);
    float* const rstdH = (float*)(ws + 24 * MiB);
    float* const ckv = ctlf + 8192;
    if (IN(1)) for (int rep = 0; rep < NREP(1); ++rep) {
        if (rep) GBAR();
        const int lane = my_tid(wave) & 63;
        {
            LAS float* scr2 = (LAS float*)(ring + wave * 16384);
            for (int it = gw; it < 8 * 128; it += NGW) { const int bb = it >> 7;
                p0_transpose_item(P.in[17], 1024, 256, WkvB + (size_t)bb * 256 * 1024, scr2, it & 127, lane, P.in[14], modKV + bb * 2048 + 1024); }
            for (int d_ = gw; d_ < 2048; d_ += NGW) { const int bb = d_ >> 8, a_ = d_ & 255;
                const bf16_t* wr_ = Wkv + (size_t)permrow(a_) * 1024 + 16 * lane; const float* sh_ = modKV + bb * 2048 + 16 * lane;
                const u32x4 w0 = *(const u32x4*)wr_, w1 = *(const u32x4*)(wr_ + 8); float acc_ = 0.f;
                acc_ += bf_lo(w0.x) * sh_[0] + bf_hi(w0.x) * sh_[1] + bf_lo(w0.y) * sh_[2] + bf_hi(w0.y) * sh_[3] + bf_lo(w0.z) * sh_[4] + bf_hi(w0.z) * sh_[5] + bf_lo(w0.w) * sh_[6] + bf_hi(w0.w) * sh_[7];
                acc_ += bf_lo(w1.x) * sh_[8] + bf_hi(w1.x) * sh_[9] + bf_lo(w1.y) * sh_[10] + bf_hi(w1.y) * sh_[11] + bf_lo(w1.z) * sh_[12] + bf_hi(w1.z) * sh_[13] + bf_lo(w1.w) * sh_[14] + bf_hi(w1.w) * sh_[15];
                acc_ = wave_sum(acc_); if (lane == 0) ckv[d_] = acc_; }
        }
        for (int chunk = gw; chunk < MROWS / 32; chunk += NGW) {
            const int bb = chunk >> 8;
            norm_chunk<false, false>(x, chunk, lane, P.in[2], modA + bb * 3072, modA + bb * 3072 + 1024, R0, nullptr, nullptr, nullptr, nullptr);
        }
    }
    SEAM(1);
    if (IN(2)) for (int rep = 0; rep < NREP(2); ++rep) {
        if (rep) GBAR();
        pg8::Gemm g{R0, WinA, MROWS, 4096, 1024}; pg8::StaticOrder S; S.init(MROWS, 4096, G, bx);
        pg8::EpiProj E{R1, (size_t)(64 * MiB), ctlf + 64, 16, 1024, 0x03201102};
        pg8::gemm_phase<pg8::EpiProj, pg8::StaticOrder, true, true>(ring, g, S, E, wave);
    }
    SEAM(2);
    if (IN(3)) for (int rep = 0; rep < NREP(3); ++rep) {
        if (rep) GBAR();
        const float lam = ctlf[0], smax2 = ctlf[1];
        const int* ctli = (const int*)ctlf; unsigned* qheads = (unsigned*)ctlf + 256 + 512 * rep;
        LAS int* misc = (LAS int*)lds;
        const int xcc = (int)(__builtin_amdgcn_s_getreg((3 << 11) | 20) & 7u);
        { const int t0_ = my_tid(wave); if (t0_ < 8) misc[8 + t0_] = ctli[16 + t0_]; misc[64 + t0_] = ctli[2048 + t0_];
          if (t0_ == 0) { int d_ = -1; for (int qi_ = 0; qi_ < 8; ++qi_) { const int bq_ = (xcc + qi_) & 7; const int ix_ = (int)atomicAdd(qheads + 64 * bq_, 1u); if (ix_ < 512) { d_ = (bq_ << 16) | ctli[2048 + ix_]; break; } } misc[1] = d_; } }
        __syncthreads();
        int cur = misc[1], par = 0, s0 = 0, pre = 0;
        bf16x8 qio[4];
#pragma unroll
        for (int k = 0; k < 4; ++k) qio[k] = (bf16x8){0, 0, 0, 0, 0, 0, 0, 0};
        while (cur >= 0) {
            const int bq = cur >> 16, h = (cur >> 6) & 7, qb = cur & 63, dd = qb * 128 - misc[8 + h];
            attnA_unit(wave, ring, ring0, s0, pre, misc + 1 + (par ^ 1), misc + 8, misc + 64, qheads, xcc, qio, bq, h, qb, dd > 0 ? dd >> 6 : 0, smax2, R1, R2, R3, R4, R0, P.in[12], lam);
            cur = misc[1 + (par ^ 1)];
            par ^= 1; s0 ^= 2; pre = 1;
        }
    }
    SEAM(3);
    if (IN(4)) for (int rep = 0; rep < NREP(4); ++rep) {
        if (rep) GBAR();
        pg8::Gemm g{R0, WoutA, MROWS, 1024, 1024}; RowOrder S; S.init(MROWS, 1024, G, bx);
        pg8::EpiRes<false, true> E{x, (void*)H, modA + 2048, 3072};
        pg8::gemm_phase<pg8::EpiRes<false, true>, RowOrder, true, true>(ring, g, S, E, wave);
    }
    if (IN(5)) {
        asm volatile("s_waitcnt vmcnt(0)" ::: "memory"); __threadfence_block(); __syncthreads();
        bf16_t* UKVb = (bf16_t*)(ws + WS_H + 128 * MiB);
        const int lane = my_tid(wave) & 63;
        for (int pm = bx; pm < MROWS / 256; pm += G) {
            const int chunk = pm * 8 + wave, bb = chunk >> 8;
            norm_chunk<true, true>(H, chunk, lane, P.in[14], modKV + bb * 2048, modKV + bb * 2048 + 1024, nullptr, P.in[19], modB + bb * 3072, modB + bb * 3072 + 1024, R1, rstdH);
        }
        asm volatile("s_waitcnt vmcnt(0)" ::: "memory"); __threadfence_block(); __syncthreads();
        { pg8::Gemm g{(const bf16_t*)H, WkvB, MROWS, 256, 1024, (size_t)256 * 1024}; RowOrder S; S.init(MROWS, 256, G, bx);
          pg8::EpiProjT<true> E{R4, (size_t)128, P.in[18], 2, 256, 0x00000001, rstdH, ckv, 256};
          pg8::gemm_phase<pg8::EpiProjT<true>, RowOrder, true, true>(ring, g, S, E, wave); }
    }
    SEAM(5);
    if (IN(6)) for (int rep = 0; rep < NREP(6); ++rep) {
        if (rep) GBAR();
        { pg8::Gemm g{R1, WinB, MROWS, 2048, 1024}; pg8::StaticOrder S; S.init(MROWS, 2048, G, bx);
          pg8::EpiProj E{R2, (size_t)(64 * MiB), P.in[23], 16, 1024, 0x00000302};
          pg8::gemm_phase<pg8::EpiProj, pg8::StaticOrder, true, true>(ring, g, S, E, wave); }
    }
    SEAM(6);
    if (IN(7)) for (int rep = 0; rep < NREP(7); ++rep) {
        if (rep) GBAR();
        {
            const float smax2B = ctlf[2];
            const int lane_ = my_tid(wave) & 63;
            int u = vcu, par = 0;
            if (u < 1024) attnB_stage(wave, lane_, ring0, u >> 7, (u >> 6) & 1, u & 63, R4);
            for (; u < 1024; u += G, par ^= 1) {
                WAIT_BAR(0);
                if (u + G < 1024) { const int u2 = u + G; attnB_stage(wave, my_tid(wave) & 63, ring0 + (par ^ 1) * 65536u, u2 >> 7, (u2 >> 6) & 1, u2 & 63, R4); }
                attnB_unit(wave, ring + par * 65536, u >> 7, (u >> 6) & 1, u & 63, smax2B, R2, R3, R1, P.in[24]);
            }
            WAIT_BAR(0);
        }
    }
    SEAM(7);
    if (IN(8)) {
        pg8::Gemm g{R1, WoutB, MROWS, 1024, 1024}; pg8::StaticOrder S; S.init(MROWS, 1024, G, bx);
        pg8::EpiRes<true, false> E{H, P.out, modB + 2048, 3072};
        pg8::gemm_phase<pg8::EpiRes<true, false>, pg8::StaticOrder, true, true>(ring, g, S, E, wave);
    }
#undef IN
#undef SEAM
}

extern "C" void kernel_launch(void* const* d_in, const int* in_sizes, int n_in, void* d_out, int out_size, void* d_ws, size_t ws_size, hipStream_t stream) {
    static int grid = 0;
    if (grid == 0) {
        if (n_in != 26 || out_size != MROWS * DM || ws_size < WS_END) { fprintf(stderr, "kernel_launch: unexpected shapes (n_in %d out %d ws %zu)\n", n_in, out_size, ws_size); grid = -1; return; }
        int dev = 0, cus = 0, per_cu = 0;
        hipGetDevice(&dev); hipDeviceGetAttribute(&cus, hipDeviceAttributeMultiprocessorCount, dev);
        hipFuncSetAttribute((const void*)yoco_fwd, hipFuncAttributeMaxDynamicSharedMemorySize, LDS_BYTES);
        if (hipOccupancyMaxActiveBlocksPerMultiprocessor(&per_cu, (const void*)yoco_fwd, NTHREADS, LDS_BYTES) != hipSuccess || per_cu < 1) { fprintf(stderr, "kernel_launch: occupancy query gave %d\n", per_cu); per_cu = 1; }
        (void)hipGetLastError();
        grid = cus * per_cu;
    }
    if (grid < 0) return;
    Params p{};
    for (int i = 0; i < 26; ++i) p.in[i] = (const float*)d_in[i];
    p.out = (float*)d_out; p.ws = (unsigned char*)d_ws; p.ph_lo = 0; p.ph_hi = 9;
    void* args[] = {&p};
    hipError_t e = hipLaunchCooperativeKernel((const void*)yoco_fwd, dim3(grid), dim3(NTHREADS), args, LDS_BYTES, stream);
    if (e != hipSuccess) fprintf(stderr, "cooperative launch failed: %s (grid %d)\n", hipGetErrorString(e), grid);
}
```

```cpp
#include <hip/hip_runtime.h>
#include <hip/hip_cooperative_groups.h>
#include <cstdio>
#include <cstdint>
namespace cg = cooperative_groups;
namespace pg8 {
#define PG8_LAS __attribute__((address_space(3)))
typedef unsigned short bf16_t;
typedef short bf16x8 __attribute__((ext_vector_type(8)));
typedef float f32x4 __attribute__((ext_vector_type(4)));
typedef unsigned u32x4 __attribute__((ext_vector_type(4)));
constexpr int BM = 256, BK = 64, HALF = 128, HTB = HALF * BK * 2  , STAGE_BYTES = 8 * HTB, NXCD = 8, WGM = 8;

__host__ __device__ __forceinline__ int lds_byte(int r, int c) { const int st = (r >> 4) * 2 + (c >> 5), rr = r & 15, cc = c & 31, ob = rr * 64 + cc * 2; return st * 1024 + (ob ^ (((ob >> 9) & 1) << 5)); }
__host__ __device__ __forceinline__ void stage_rc(int b, int& R, int& C) { const int st = b / 1024, sb = b % 1024, swz = sb ^ (((sb >> 9) & 1) << 5); R = (st >> 1) * 16 + swz / 64; C = (st & 1) * 32 + (swz % 64) / 2; }
__host__ __device__ __forceinline__ int perm32(int rho) { const int n = rho >> 4, i = rho & 15; return 8 * (i >> 2) + 4 * n + (i & 3); }

struct Unit { int pm, pn; };
struct Gemm { const bf16_t* A; const bf16_t* Bt; int M, N, K; size_t bstride = 0; };

struct StaticOrder {
    int nM, nN, nwg, G, c;
    __host__ __device__ void init(int M, int N, int G_, int c_) { nM = M / BM; nN = N / BM; nwg = nM * nN; G = G_; c = c_; }
    __host__ __device__ bool next(int i, Unit& u) const {
        const long L = (long)i * G + c; if (L >= nwg) return false;
        int wgid = (int)L; { const int q = nwg / NXCD, r = nwg % NXCD, xcd = wgid % NXCD, off = wgid / NXCD; wgid = (xcd < r ? xcd * (q + 1) : r * (q + 1) + (xcd - r) * q) + off; }
        const int nig = WGM * nN, gid = wgid / nig, fm = gid * WGM, gsz = (nM - fm) < WGM ? (nM - fm) : WGM;
        u.pm = fm + ((wgid % nig) % gsz); u.pn = (wgid % nig) / gsz; return true;
    }
    __device__ __forceinline__ void a_ready(const Unit&) const {}
    __device__ __forceinline__ void done(const Unit&) const {}
};

__device__ __forceinline__ unsigned cvt_pk_bf16(float lo, float hi) { unsigned r; asm volatile("v_cvt_pk_bf16_f32 %0, %1, %2" : "=v"(r) : "v"(lo), "v"(hi)); return r; }
typedef unsigned u32x4e __attribute__((ext_vector_type(4)));
constexpr float QK_C2 = 0.125f * 1.4426950408889634f;
template <bool AFF> struct EpiProjT {
    static constexpr bool PERM = true, AFTER_DRAIN = false;
    bf16_t* out0; size_t tstride;
    const float* gtab;
    int hpt, ldo;
    int modes;
    const float* rstd = nullptr; const float* cbias = nullptr; int cb_ld = 0;
    __device__ __forceinline__ void operator()(const f32x4 (&acc)[2][2][4][2], const Unit& u, int wr, int wc, int fr, int fq) const {
        const int head = u.pn * 4 + wc, ty = head / hpt, hh = head - ty * hpt;
        bf16_t* base = out0 + (size_t)ty * tstride;
        const int mode = (modes >> (8 * ty)) & 15, lay = (modes >> (8 * ty + 4)) & 15;
        const float* g = gtab + 64 * ty;
        int row0 = u.pm * BM + wr * 64 + fr, colh = hh * 64 + 8 * fq, ldo = this->ldo;
        const int trow0 = row0;
        f32x4 cbv[2][2];
#pragma unroll
        for (int bj = 0; bj < 2; ++bj)
#pragma unroll
            for (int n = 0; n < 2; ++n) cbv[bj][n] = AFF ? *(const f32x4*)(cbias + (size_t)(u.pm >> 5) * cb_ld + head * 64 + 32 * bj + 8 * fq + 4 * n) : (f32x4){0.f, 0.f, 0.f, 0.f};
        if (lay == 1) { const int bb = row0 >> 13; row0 = (bb * hpt + hh) * 8192 + (row0 & 8191); colh = 8 * fq; ldo = 64; }
        else if (lay == 2) { const int bb = row0 >> 13; row0 = (bb * (hpt >> 1) + (hh >> 1)) * 8192 + (row0 & 8191); colh = (hh & 1) * 64 + 8 * fq; ldo = 128; }
        if (mode == 1 || mode == 2) {
            const float gs = mode == 2 ? QK_C2 : 1.0f;
            f32x4 gv[2][2];
#pragma unroll
            for (int bj = 0; bj < 2; ++bj)
#pragma unroll
                for (int n = 0; n < 2; ++n) gv[bj][n] = *(const f32x4*)(g + 32 * bj + 8 * fq + 4 * n) * gs;
#pragma unroll
            for (int ai = 0; ai < 2; ++ai)
#pragma unroll
                for (int m = 0; m < 4; ++m) {
                    const float rs_ = AFF ? rstd[trow0 + ai * HALF + m * 16] : 1.0f;
                    f32x4 xv[2][2];
                    float ss = 0.f;
#pragma unroll
                    for (int bj = 0; bj < 2; ++bj)
#pragma unroll
                        for (int n = 0; n < 2; ++n) { const f32x4 x = AFF ? acc[ai][bj][m][n] * rs_ + cbv[bj][n] : acc[ai][bj][m][n]; xv[bj][n] = x; ss += (x[0] * x[0] + x[1] * x[1]) + (x[2] * x[2] + x[3] * x[3]); }
                    { auto r16 = __builtin_amdgcn_permlane16_swap(__float_as_uint(ss), __float_as_uint(ss), false, false); ss = __uint_as_float(r16[0]) + __uint_as_float(r16[1]);
                      auto r32 = __builtin_amdgcn_permlane32_swap(__float_as_uint(ss), __float_as_uint(ss), false, false); ss = __uint_as_float(r32[0]) + __uint_as_float(r32[1]); }
                    const float rstd_h = rsqrtf(ss * (1.0f / 64.0f) + 1e-6f);
                    bf16_t* rowp = base + (size_t)(row0 + ai * HALF + m * 16) * ldo + colh;
#pragma unroll
                    for (int bj = 0; bj < 2; ++bj) { const f32x4 v0 = xv[bj][0] * rstd_h * gv[bj][0], v1 = xv[bj][1] * rstd_h * gv[bj][1];
                        u32x4e w; w.x = cvt_pk_bf16(v0[0], v0[1]); w.y = cvt_pk_bf16(v0[2], v0[3]); w.z = cvt_pk_bf16(v1[0], v1[1]); w.w = cvt_pk_bf16(v1[2], v1[3]);
                        *(u32x4e*)(rowp + bj * 32) = w; }
                }
        } else {
#pragma unroll
            for (int ai = 0; ai < 2; ++ai)
#pragma unroll
                for (int m = 0; m < 4; ++m) {
                    bf16_t* rowp = base + (size_t)(row0 + ai * HALF + m * 16) * ldo + colh;
                    const float rs_ = AFF ? rstd[trow0 + ai * HALF + m * 16] : 1.0f;
#pragma unroll
                    for (int bj = 0; bj < 2; ++bj) { f32x4 v0 = acc[ai][bj][m][0], v1 = acc[ai][bj][m][1]; if (AFF) { v0 = v0 * rs_ + cbv[bj][0]; v1 = v1 * rs_ + cbv[bj][1]; }
                        if (mode == 3) {
#pragma unroll
                            for (int e = 0; e < 4; ++e) { v0[e] = v0[e] * __builtin_amdgcn_rcpf(1.0f + __expf(-v0[e])); v1[e] = v1[e] * __builtin_amdgcn_rcpf(1.0f + __expf(-v1[e])); } }
                        u32x4e w; w.x = cvt_pk_bf16(v0[0], v0[1]); w.y = cvt_pk_bf16(v0[2], v0[3]); w.z = cvt_pk_bf16(v1[0], v1[1]); w.w = cvt_pk_bf16(v1[2], v1[3]);
                        *(u32x4e*)(rowp + bj * 32) = w; }
                }
        }
    }
};
typedef EpiProjT<false> EpiProj;
template <bool BASE_BF16, bool OUT_BF16> struct EpiRes {
    static constexpr bool PERM = true, AFTER_DRAIN = false;
    const void* base; void* out; const float* gate; int ldg;
    __device__ __forceinline__ void operator()(const f32x4 (&acc)[2][2][4][2], const Unit& u, int wr, int wc, int fr, int fq) const {
        const int col = (u.pn * 4 + wc) * 64 + 8 * fq, row0 = u.pm * BM + wr * 64 + fr;
        const float* gp = gate + (size_t)(u.pm >> 5) * ldg + col;
        f32x4 gv[2][2];
#pragma unroll
        for (int bj = 0; bj < 2; ++bj)
#pragma unroll
            for (int n = 0; n < 2; ++n) gv[bj][n] = *(const f32x4*)(gp + 32 * bj + 4 * n);
#pragma unroll
        for (int ai = 0; ai < 2; ++ai) {
            f32x4 bs[4][2][2];
#pragma unroll
            for (int m = 0; m < 4; ++m) { const size_t off = (size_t)(row0 + ai * HALF + m * 16) * 1024 + col;
#pragma unroll
                for (int bj = 0; bj < 2; ++bj) {
                    if (BASE_BF16) { const u32x4e w = *(const u32x4e*)((const bf16_t*)base + off + 32 * bj);
                        bs[m][bj][0] = (f32x4){__uint_as_float(w.x << 16), __uint_as_float(w.x & 0xffff0000u), __uint_as_float(w.y << 16), __uint_as_float(w.y & 0xffff0000u)};
                        bs[m][bj][1] = (f32x4){__uint_as_float(w.z << 16), __uint_as_float(w.z & 0xffff0000u), __uint_as_float(w.w << 16), __uint_as_float(w.w & 0xffff0000u)}; }
                    else { bs[m][bj][0] = *(const f32x4*)((const float*)base + off + 32 * bj); bs[m][bj][1] = *(const f32x4*)((const float*)base + off + 32 * bj + 4); } } }
            asm volatile("" ::: "memory");
#pragma unroll
            for (int m = 0; m < 4; ++m) { const size_t off = (size_t)(row0 + ai * HALF + m * 16) * 1024 + col;
#pragma unroll
                for (int bj = 0; bj < 2; ++bj) { const f32x4 v0 = bs[m][bj][0] + gv[bj][0] * acc[ai][bj][m][0], v1 = bs[m][bj][1] + gv[bj][1] * acc[ai][bj][m][1];
                    if (OUT_BF16) { u32x4e w; w.x = cvt_pk_bf16(v0[0], v0[1]); w.y = cvt_pk_bf16(v0[2], v0[3]); w.z = cvt_pk_bf16(v1[0], v1[1]); w.w = cvt_pk_bf16(v1[2], v1[3]); *(u32x4e*)((bf16_t*)out + off + 32 * bj) = w; }
                    else { __builtin_nontemporal_store(v0, (f32x4*)((float*)out + off + 32 * bj)); __builtin_nontemporal_store(v1, (f32x4*)((float*)out + off + 32 * bj + 4)); } } }
            asm volatile("" ::: "memory");
        }
    }
};
template <class Epi, class Sched, bool ALIGN_EPI = false, bool SP2 = false>
__device__ __forceinline__ void gemm_phase(PG8_LAS unsigned char* lds, const Gemm g, const Sched& S, const Epi& E, const int wave_) {
    int tid; { int l_; asm volatile("v_mbcnt_lo_u32_b32 %0, -1, 0\n\tv_mbcnt_hi_u32_b32 %0, -1, %0" : "=v"(l_)); tid = wave_ * 64 + l_; }
    const int wid = __builtin_amdgcn_readfirstlane(tid >> 6), lane = tid & 63, wr = wid >> 2, wc = wid & 3, fr = lane & 15, fq = lane >> 4;
    const int K = g.K, nt = K / BK;
    unsigned voffA[2], voffB[2];
#pragma unroll
    for (int i = 0; i < 2; ++i) { int R, C; stage_rc(tid * 16 + i * 8192, R, C); const int Rb = Epi::PERM ? ((R & ~31) + perm32(R & 31)) : R;
        voffA[i] = (unsigned)(R * K + C) * 2u; voffB[i] = (unsigned)(Rb * K + C) * 2u; }
    const size_t kstep = (size_t)(BK * 2);
    const size_t hstep = (size_t)HALF * K * 2;
    const size_t tstep = 2 * hstep;
    const unsigned ldsw = (unsigned)wid * 1024u;
    const int aoff = lds_byte(wr * 64 + fr, fq * 8), boff = lds_byte(wc * 32 + fr, fq * 8);
#define PG8_SA(b, h) (((b) * 2 + (h)) * HTB)
#define PG8_SB(b, h) ((4 + (b) * 2 + (h)) * HTB)
#define PG8_STAGE(bufoff, gbase, voff) do { _Pragma("unroll") for (int _i = 0; _i < 2; ++_i) \
        __builtin_amdgcn_global_load_lds((const unsigned*)((const char*)(gbase) + (voff)[_i]), (PG8_LAS unsigned*)(lds + (bufoff) + ldsw + _i * 8192), 16, 0, 0); } while (0)
#define PG8_LDA(dst, b, h) do { _Pragma("unroll") for (int m = 0; m < 4; ++m) _Pragma("unroll") for (int k = 0; k < 2; ++k) dst[m][k] = *(const PG8_LAS bf16x8*)(lds + PG8_SA(b, h) + aoff + m * 2048 + k * 1024); } while (0)
#define PG8_LDB(dst, b, h) do { _Pragma("unroll") for (int n = 0; n < 2; ++n) _Pragma("unroll") for (int k = 0; k < 2; ++k) dst[n][k] = *(const PG8_LAS bf16x8*)(lds + PG8_SB(b, h) + boff + n * 2048 + k * 1024); } while (0)
#define PG8_MMA(ai, bj, At, Bt) do { __builtin_amdgcn_s_setprio(1); _Pragma("unroll") for (int m = 0; m < 4; ++m) _Pragma("unroll") for (int n = 0; n < 2; ++n) _Pragma("unroll") for (int k = 0; k < 2; ++k) \
        acc[ai][bj][m][n] = __builtin_amdgcn_mfma_f32_16x16x32_bf16(Bt[n][k], At[m][k], acc[ai][bj][m][n], 0, 0, 0); __builtin_amdgcn_s_setprio(0); } while (0)
#define PG8_WAIT_V(n) asm volatile("s_waitcnt vmcnt(" #n ")" ::: "memory")
#define PG8_WAIT_L(n) asm volatile("s_waitcnt lgkmcnt(" #n ")" ::: "memory")
#define PG8_BAR __builtin_amdgcn_s_barrier()
#define PG8_SCHED __builtin_amdgcn_sched_barrier(0)
    Unit cur, nxt; int ui = 0;
    if (!S.next(0, cur)) return;
    f32x4 acc[2][2][4][2];
#pragma unroll
    for (int a = 0; a < 2; ++a)
#pragma unroll
        for (int b = 0; b < 2; ++b)
#pragma unroll
            for (int m = 0; m < 4; ++m)
#pragma unroll
                for (int n = 0; n < 2; ++n) acc[a][b][m][n] = (f32x4){0.f, 0.f, 0.f, 0.f};
    bf16x8 At[4][2], B0[2][2], B1[2][2];
    const char* cA = (const char*)g.A + (size_t)cur.pm * tstep; const char* cB = (const char*)g.Bt + (size_t)cur.pn * tstep + (size_t)(cur.pm >> 5) * g.bstride * 2;
    S.a_ready(cur);
    if constexpr (SP2) {
        PG8_STAGE(PG8_SB(0, 0), cB, voffB); PG8_STAGE(PG8_SB(0, 1), cB + hstep, voffB); PG8_STAGE(PG8_SA(0, 0), cA, voffA); PG8_STAGE(PG8_SA(0, 1), cA + hstep, voffA);
        if (wr == 1) PG8_BAR;
        PG8_WAIT_V(2); PG8_BAR;
        PG8_STAGE(PG8_SB(1, 0), cB + kstep, voffB); PG8_STAGE(PG8_SA(1, 0), cA + kstep, voffA); PG8_STAGE(PG8_SB(1, 1), cB + hstep + kstep, voffB);
        PG8_WAIT_V(6); PG8_BAR;
    } else {
        PG8_STAGE(PG8_SB(0, 0), cB, voffB); PG8_STAGE(PG8_SA(0, 0), cA, voffA); PG8_STAGE(PG8_SB(0, 1), cB + hstep, voffB); PG8_STAGE(PG8_SA(0, 1), cA + hstep, voffA);
        if (wr == 1) PG8_BAR;
        PG8_WAIT_V(4); PG8_BAR;
        PG8_STAGE(PG8_SB(1, 0), cB + kstep, voffB); PG8_STAGE(PG8_SA(1, 0), cA + kstep, voffA); PG8_STAGE(PG8_SB(1, 1), cB + hstep + kstep, voffB);
        PG8_WAIT_V(6); PG8_BAR;
    }
    for (;;) {
        const bool has_next = S.next(ui + 1, nxt);
        const char* nA = has_next ? (const char*)g.A + (size_t)nxt.pm * tstep : cA; const char* nB = has_next ? (const char*)g.Bt + (size_t)nxt.pn * tstep + (size_t)(nxt.pm >> 5) * g.bstride * 2 : cB;
        for (int t = 0; t < nt; t += 2) {
            const bool last = (t == nt - 2);
            const char* a1 = cA + (size_t)(t + 1) * kstep;
            const char* a2 = last ? nA : cA + (size_t)(t + 2) * kstep; const char* b2 = last ? nB : cB + (size_t)(t + 2) * kstep;
            const char* a3 = a2 + kstep; const char* b3 = b2 + kstep;
            if (last && has_next) S.a_ready(nxt);
            if constexpr (SP2) {
            PG8_LDB(B0, 0, 0); PG8_LDB(B1, 0, 1); PG8_SCHED; PG8_LDA(At, 0, 0); PG8_STAGE(PG8_SA(1, 1), a1 + hstep, voffA);
            PG8_WAIT_V(8); PG8_WAIT_L(0); PG8_BAR; PG8_MMA(0, 0, At, B0); PG8_MMA(0, 1, At, B1); PG8_BAR; PG8_SCHED;
            PG8_LDA(At, 0, 1); PG8_STAGE(PG8_SB(0, 0), b2, voffB); PG8_STAGE(PG8_SB(0, 1), b2 + hstep, voffB); PG8_STAGE(PG8_SA(0, 0), a2, voffA);
            PG8_WAIT_V(8); PG8_WAIT_L(0); PG8_BAR; PG8_MMA(1, 0, At, B0); PG8_MMA(1, 1, At, B1); PG8_BAR; PG8_SCHED;
            PG8_LDB(B0, 1, 0); PG8_LDB(B1, 1, 1); PG8_SCHED; PG8_LDA(At, 1, 0); PG8_STAGE(PG8_SA(0, 1), a2 + hstep, voffA);
            PG8_WAIT_V(8); PG8_WAIT_L(0); PG8_BAR; PG8_MMA(0, 0, At, B0); PG8_MMA(0, 1, At, B1); PG8_BAR; PG8_SCHED;
            PG8_LDA(At, 1, 1); PG8_STAGE(PG8_SB(1, 0), b3, voffB); PG8_STAGE(PG8_SB(1, 1), b3 + hstep, voffB); PG8_STAGE(PG8_SA(1, 0), a3, voffA);
            PG8_WAIT_V(8); PG8_WAIT_L(0); PG8_BAR; PG8_MMA(1, 0, At, B0); PG8_MMA(1, 1, At, B1); PG8_BAR; PG8_SCHED;
            } else {
            PG8_LDB(B0, 0, 0); PG8_SCHED; PG8_LDA(At, 0, 0); PG8_STAGE(PG8_SA(1, 1), a1 + hstep, voffA);
            PG8_WAIT_L(8); PG8_BAR; PG8_WAIT_L(0); PG8_MMA(0, 0, At, B0); PG8_BAR; PG8_SCHED;
            PG8_LDB(B1, 0, 1); PG8_STAGE(PG8_SB(0, 0), b2, voffB);
            PG8_BAR; PG8_WAIT_L(0); PG8_MMA(0, 1, At, B1); PG8_BAR;
            PG8_LDA(At, 0, 1); PG8_STAGE(PG8_SA(0, 0), a2, voffA);
            PG8_BAR; PG8_WAIT_L(0); PG8_MMA(1, 0, At, B0); PG8_BAR; PG8_SCHED;
            PG8_STAGE(PG8_SB(0, 1), b2 + hstep, voffB);
            PG8_WAIT_V(6); PG8_BAR; PG8_MMA(1, 1, At, B1); PG8_BAR;
            PG8_LDB(B0, 1, 0); PG8_SCHED; PG8_LDA(At, 1, 0); PG8_STAGE(PG8_SA(0, 1), a2 + hstep, voffA);
            PG8_WAIT_L(8); PG8_BAR; PG8_WAIT_L(0); PG8_MMA(0, 0, At, B0); PG8_BAR; PG8_SCHED;
            PG8_LDB(B1, 1, 1); PG8_STAGE(PG8_SB(1, 0), b3, voffB);
            PG8_BAR; PG8_WAIT_L(0); PG8_MMA(0, 1, At, B1); PG8_BAR;
            PG8_LDA(At, 1, 1); PG8_STAGE(PG8_SA(1, 0), a3, voffA);
            PG8_BAR; PG8_WAIT_L(0); PG8_MMA(1, 0, At, B0); PG8_BAR; PG8_SCHED;
            PG8_STAGE(PG8_SB(1, 1), b3 + hstep, voffB);
            PG8_WAIT_V(6); PG8_BAR; PG8_MMA(1, 1, At, B1); PG8_BAR;
            }
        }
        if constexpr (ALIGN_EPI) { if (wr == 0) PG8_BAR; }
        if constexpr (!Epi::AFTER_DRAIN) { E(acc, cur, wr, wc, fr, fq); S.done(cur); }
        if (!has_next) break;
#pragma unroll
        for (int a = 0; a < 2; ++a)
#pragma unroll
            for (int b = 0; b < 2; ++b)
#pragma unroll
                for (int m = 0; m < 4; ++m)
#pragma unroll
                    for (int n = 0; n < 2; ++n) acc[a][b][m][n] = (f32x4){0.f, 0.f, 0.f, 0.f};
        cur = nxt; cA = nA; cB = nB; ++ui;
        if constexpr (ALIGN_EPI) { if (wr == 1) PG8_BAR; }
    }
    PG8_WAIT_V(0);
    if constexpr (!ALIGN_EPI) { if (wr == 0) PG8_BAR; }
    PG8_BAR;
    if constexpr (Epi::AFTER_DRAIN) { E.fused(acc, cur, wr, wc, fr, fq, lds, wid, lane); S.done(cur); }
#undef PG8_SA
#undef PG8_SB
#undef PG8_STAGE
#undef PG8_LDA
#undef PG8_LDB
#undef PG8_MMA
#undef PG8_WAIT_V
#undef PG8_WAIT_L
#undef PG8_BAR
#undef PG8_SCHED
}
}
constexpr int BATCH = 8, SEQ = 8192, DM = 1024, MROWS = BATCH * SEQ;
constexpr float LOG2E = 1.4426950408889634f;
constexpr size_t MiB = 1u << 20;
constexpr size_t WS_CTL = 0, WS_MOD = 1 * MiB, WS_WINA = 2 * MiB, WS_WOUTA = 10 * MiB, WS_WKV = 12 * MiB, WS_WINB = 13 * MiB, WS_WOUTB = 17 * MiB;
constexpr size_t WS_R0 = 32 * MiB, WS_R1 = 160 * MiB, WS_R2 = 288 * MiB, WS_R3 = 416 * MiB, WS_R4 = 544 * MiB, WS_H = 672 * MiB, WS_END = 928 * MiB;
constexpr int LDS_BYTES = 147456;
constexpr int NTHREADS = 512;

#define LAS __attribute__((address_space(3)))
typedef unsigned short bf16_t;
typedef short bf16x8 __attribute__((ext_vector_type(8)));
typedef short s16x4 __attribute__((ext_vector_type(4)));
typedef float f32x4 __attribute__((ext_vector_type(4)));
typedef float f32x16 __attribute__((ext_vector_type(16)));
typedef unsigned u32x4 __attribute__((ext_vector_type(4)));
typedef unsigned u32x2 __attribute__((ext_vector_type(2)));
typedef LAS const unsigned char* lds_cptr;

__device__ __forceinline__ unsigned cvtpk(float lo, float hi) { unsigned r; asm("v_cvt_pk_bf16_f32 %0, %1, %2" : "=v"(r) : "v"(lo), "v"(hi)); return r; }
__device__ __forceinline__ float bf_lo(unsigned w) { return __uint_as_float(w << 16); }
__device__ __forceinline__ float bf_hi(unsigned w) { return __uint_as_float(w & 0xffff0000u); }
__device__ __forceinline__ float wave_sum(float v) {
#pragma unroll
    for (int o = 1; o < 64; o <<= 1) v += __shfl_xor(v, o);
    return v;
}
__device__ __forceinline__ float half_swap_max(float m) { auto rr = __builtin_amdgcn_permlane32_swap(__float_as_uint(m), __float_as_uint(m), false, false); return fmaxf(__uint_as_float(rr[0]), __uint_as_float(rr[1])); }
__device__ __forceinline__ float half_swap_sum(float m) { auto rr = __builtin_amdgcn_permlane32_swap(__float_as_uint(m), __float_as_uint(m), false, false); return __uint_as_float(rr[0]) + __uint_as_float(rr[1]); }
__device__ __forceinline__ int my_tid(int wave) { int l_; asm volatile("v_mbcnt_lo_u32_b32 %0, -1, 0\n\tv_mbcnt_hi_u32_b32 %0, -1, %0" : "=v"(l_)); return wave * 64 + l_; }
#define XB_TMO      128
#define XB_XCNT(j)  (256  + 64 * (j))
#define XB_XSUB(j)  (1280 + 64 * (j))
#define XB_XGEN(j)  (2304 + 64 * (j))
#define XB_TOP      3328
#define XB_TOPGEN   3392
#define XCD_BAR_WORDS 3456
#define XB_SPIN_CAP (1u << 23)
__device__ __forceinline__ unsigned xb_ld(unsigned* p)              { return __hip_atomic_load(p, __ATOMIC_RELAXED, __HIP_MEMORY_SCOPE_AGENT); }
__device__ __forceinline__ unsigned xb_add(unsigned* p, unsigned v) { return __hip_atomic_fetch_add(p, v, __ATOMIC_RELAXED, __HIP_MEMORY_SCOPE_AGENT); }
#define XB_SPIN(cond, bar) do { unsigned _sp = 0; while (cond) { __builtin_amdgcn_s_sleep(1); \
    if ((++_sp & 255u) == 0u) { if (xb_ld(&(bar)[XB_TMO])) break; if (_sp > XB_SPIN_CAP) { atomicAdd(&(bar)[XB_TMO], 1u); break; } } } } while (0)
__device__ __forceinline__ void grid_bar(unsigned* bar, const unsigned x, volatile LAS unsigned* st, int wave) {
    asm volatile("s_waitcnt vmcnt(0)" ::: "memory");
    __syncthreads();
    if (my_tid(wave) == 0) {
        __builtin_amdgcn_s_waitcnt(0);
        unsigned nloc = st[0], nx = st[1];
        if (nloc == 0u) {
            const unsigned G_ = gridDim.x; unsigned sum, cnt, mine, sp = 0u;
            for (;;) {
                sum = 0u; cnt = 0u; mine = 0u;
#pragma unroll
                for (unsigned jx = 0; jx < 16; ++jx) { const unsigned c_ = xb_ld(&bar[XB_XCNT(jx)]); sum += c_; cnt += (c_ > 0u) ? 1u : 0u; mine = (jx == x) ? c_ : mine; }
                if (sum == G_) break;
                __builtin_amdgcn_s_sleep(1);
                if ((++sp & 255u) == 0u) { if (xb_ld(&bar[XB_TMO])) break; if (sp > XB_SPIN_CAP) { atomicAdd(&bar[XB_TMO], 1u); break; } }
            }
            nloc = mine > 0u ? mine : 1u; nx = cnt > 0u ? cnt : 1u; st[0] = nloc; st[1] = nx;
        }
        const unsigned old = xb_add(&bar[XB_XSUB(x)], 1u);
        const unsigned gen = old / nloc;
        if (old + 1u == (gen + 1u) * nloc) {
            __builtin_amdgcn_fence(__ATOMIC_RELEASE, "agent");
            asm volatile("s_waitcnt vmcnt(0)" ::: "memory");
            const unsigned og = xb_add(&bar[XB_TOP], 1u);
            const unsigned tg = og / nx;
            if (og + 1u == (tg + 1u) * nx) xb_add(&bar[XB_TOPGEN], 1u);
            else XB_SPIN(xb_ld(&bar[XB_TOPGEN]) == tg, bar);
            __builtin_amdgcn_fence(__ATOMIC_ACQUIRE, "agent");
            xb_add(&bar[XB_XGEN(x)], 1u);
            asm volatile("s_waitcnt vmcnt(0)" ::: "memory");
        } else {
            XB_SPIN(xb_ld(&bar[XB_XGEN(x)]) == gen, bar);
            __builtin_amdgcn_fence(__ATOMIC_ACQUIRE, "agent");
            asm volatile("s_waitcnt vmcnt(0)" ::: "memory");
        }
    }
    __syncthreads();
}
__device__ __forceinline__ int crow(int r, int hi) { return (r & 3) + 8 * (r >> 2) + 4 * hi; }
__device__ __forceinline__ void glds16(const void* g, unsigned lds_base) {
    unsigned sv; asm volatile("s_mov_b32 %0, m0\n\ts_mov_b32 m0, %2\n\ts_nop 0\n\tglobal_load_lds_dwordx4 %1, off\n\ts_mov_b32 m0, %0" : "=&s"(sv) : "v"(g), "s"(lds_base) : "memory"); }
#define GLDS(g, dst) glds16((g), (unsigned)__builtin_amdgcn_readfirstlane((int)(dst)))
#define WAIT_BAR(N) asm volatile("s_waitcnt vmcnt(" #N ") lgkmcnt(0)\n\ts_barrier" ::: "memory")
#define LDS_WAIT() asm volatile("s_waitcnt lgkmcnt(0)" ::: "memory")
typedef short v4i16_t __attribute__((ext_vector_type(4)));
__device__ __forceinline__ s16x4 vtr(lds_cptr p) { return __builtin_bit_cast(s16x4, __builtin_amdgcn_ds_read_tr16_b64_v4i16((LAS v4i16_t*)p)); }
#define MFMA32(a, b, c) __builtin_amdgcn_mfma_f32_32x32x16_bf16((a), (b), (c), 0, 0, 0)

__device__ __forceinline__ void pack_p(bf16x8 (&pf)[4], const f32x16& p0, const f32x16& p1) {
    u32x4 w;
    w.x = cvtpk(p0[0], p0[1]); w.y = cvtpk(p0[2], p0[3]); w.z = cvtpk(p0[4], p0[5]); w.w = cvtpk(p0[6], p0[7]); pf[0] = __builtin_bit_cast(bf16x8, w);
    w.x = cvtpk(p0[8], p0[9]); w.y = cvtpk(p0[10], p0[11]); w.z = cvtpk(p0[12], p0[13]); w.w = cvtpk(p0[14], p0[15]); pf[1] = __builtin_bit_cast(bf16x8, w);
    w.x = cvtpk(p1[0], p1[1]); w.y = cvtpk(p1[2], p1[3]); w.z = cvtpk(p1[4], p1[5]); w.w = cvtpk(p1[6], p1[7]); pf[2] = __builtin_bit_cast(bf16x8, w);
    w.x = cvtpk(p1[8], p1[9]); w.y = cvtpk(p1[10], p1[11]); w.z = cvtpk(p1[12], p1[13]); w.w = cvtpk(p1[14], p1[15]); pf[3] = __builtin_bit_cast(bf16x8, w);
}
constexpr int ASLOT = 32768;
__device__ __forceinline__ void attnA_unit(const int wave_, LAS unsigned char* lds, unsigned lds0, const int s0, const int pre, LAS int* nextw, const LAS int* cuts, const LAS int* utab, unsigned* qheads, const int xcc, bf16x8 (&qio)[4],
                                           int b, int h, int qb, int t_lo, float smax2,
                                           const bf16_t* QA, const bf16_t* KA, const bf16_t* VA, const bf16_t* ZA, bf16_t* OA, const float* subg, float lam) {
    const int tid = my_tid(wave_);
    const int lane = tid & 63, r32 = lane & 31, hi = lane >> 5;
    const int wid = wave_, j = wid >> 2, wq = wid & 3;
    const int q0 = qb * 128, NT = (q0 + 128) / 64 - t_lo;
    const size_t rowbase = (size_t)b * SEQ;
    const int qloc = 32 * wq + r32, qpos = q0 + qloc;
    const float slope2 = exp2f(-(float)(h + 1)) * LOG2E;
    bf16x8 qf[4];
    if (pre) {
#pragma unroll
        for (int d0 = 0; d0 < 4; ++d0) qf[d0] = qio[d0];
    } else { const bf16_t* Qw = QA + (rowbase + qpos) * 1024 + (2 * h + j) * 64 + hi * 8;
#pragma unroll
      for (int d0 = 0; d0 < 4; ++d0) qf[d0] = *(const bf16x8*)(Qw + d0 * 16); }
    const int krow = 8 * wid + (lane >> 3), kch = (lane & 7) ^ ((krow >> 1) & 7);
    const bf16_t* ksrc0 = KA + ((size_t)(b * 16 + 2 * h) * SEQ + krow) * 64 + kch * 8;
    const int pva = 2 * wid, pvb = 2 * wid + 1, vch = (lane & 15) ^ (((lane >> 4) & 3) << 2);
    const bf16_t* vsrcA = VA + ((size_t)(b * 8 + h) * SEQ + 4 * pva + (lane >> 4)) * 128 + vch * 8;
    const bf16_t* vsrcB = vsrcA + 4 * 128;
    const int klane = krow * 64 + kch * 8, vlane = (4 * pva + (lane >> 4)) * 128 + vch * 8;
    const unsigned kdst = lds0 + wid * 1024, vdstA = lds0 + 16384 + pva * 1024, vdstB = lds0 + 16384 + pvb * 1024;
#define DMA_TILE(t, sl) do { const size_t ko_ = (size_t)(t) * 64 * 64, vo_ = (size_t)(t) * 64 * 128; const unsigned so_ = (unsigned)(sl) * ASLOT; \
        GLDS(ksrc0 + ko_, kdst + so_); GLDS(ksrc0 + (size_t)SEQ * 64 + ko_, kdst + 8192 + so_); GLDS(vsrcA + vo_, vdstA + so_); GLDS(vsrcB + vo_, vdstB + so_); } while (0)
    asm volatile("" ::: "memory");
    if (!pre) { DMA_TILE(t_lo, s0);
        if (NT > 1) DMA_TILE(t_lo + 1, s0 + 1); }
    if (NT > 2) DMA_TILE(t_lo + 2, (s0 + 2) & 3);
    f32x16 bias0;
#pragma unroll
    for (int r = 0; r < 16; ++r) bias0[r] = slope2 * (float)(crow(r, hi) - qloc);
    const float s32 = 32.f * slope2;
    float l = 0.f;
    f32x16 o[4];
#pragma unroll
    for (int db = 0; db < 4; ++db)
#pragma unroll
        for (int r = 0; r < 16; ++r) o[db][r] = 0.f;
    const int kofs = j * 8192 + r32 * 128;
    const int kx0 = (hi ^ ((r32 >> 1) & 7)) * 16;
    const int vx0 = 256 * (4 * hi + ((lane & 15) >> 2)) + 16 * (4 * ((lane >> 2) & 3) + 2 * ((lane >> 4) & 1) + ((lane >> 1) & 1)) + 8 * (lane & 1);
    const int qfirst = q0 + 32 * wq, qlast = qfirst + 31;
    const int NTw = (64 * (t_lo + NT - 1) <= qlast) ? NT : NT - 1;
    f32x16 p0, p1;
#define SB0() __builtin_amdgcn_sched_barrier(0)
#define PINV(x) asm volatile("" : "+v"(x))
#define KLD(kf, sl, d0) do { const lds_cptr kb_ = (lds_cptr)lds + (sl) * ASLOT + kofs + (kx0 ^ (32 * (d0))); kf[0] = *(const LAS bf16x8*)(kb_); kf[1] = *(const LAS bf16x8*)(kb_ + 4096); } while (0)
    struct VF1 { s16x4 lo, hh; };
#define VLD1(vf, sl, g_) do { const lds_cptr vb_ = (lds_cptr)lds + (sl) * ASLOT + 16384 + (vx0 ^ (64 * ((g_) >> 2))) + ((g_) & 3) * 4096; vf.lo = vtr(vb_); vf.hh = vtr(vb_ + 2048); } while (0)
#define VF8(vf) ((bf16x8){vf.lo[0], vf.lo[1], vf.lo[2], vf.lo[3], vf.hh[0], vf.hh[1], vf.hh[2], vf.hh[3]})
#define QK8(sl) do { bf16x8 ka[2], kb2[2], kc[2], kd[2]; \
        KLD(ka, sl, 0); KLD(kb2, sl, 1); KLD(kc, sl, 2); KLD(kd, sl, 3); SB0(); \
        p0 = MFMA32(ka[0], qf[0], bias0); p1 = MFMA32(ka[1], qf[0], bias0); p0 = MFMA32(kb2[0], qf[1], p0); p1 = MFMA32(kb2[1], qf[1], p1); \
        p0 = MFMA32(kc[0], qf[2], p0); p1 = MFMA32(kc[1], qf[2], p1); p0 = MFMA32(kd[0], qf[3], p0); p1 = MFMA32(kd[1], qf[3], p1); SB0(); } while (0)
#define KLOADS(sl) bf16x8 ka[2], kb2[2], kc[2], kd[2]; KLD(ka, sl, 0); KLD(kb2, sl, 1); KLD(kc, sl, 2); KLD(kd, sl, 3); SB0()
#define QKMMA() do { p0 = MFMA32(ka[0], qf[0], bias0); p1 = MFMA32(ka[1], qf[0], bias0); p0 = MFMA32(kb2[0], qf[1], p0); p1 = MFMA32(kb2[1], qf[1], p1); \
        p0 = MFMA32(kc[0], qf[2], p0); p1 = MFMA32(kc[1], qf[2], p1); p0 = MFMA32(kd[0], qf[3], p0); p1 = MFMA32(kd[1], qf[3], p1); SB0(); } while (0)
#define MASK(t) do { if (64 * (t) + 63 > qfirst) { const int qh = qpos - 64 * (t) - 4 * hi; \
            _Pragma("unroll") for (int r = 0; r < 16; ++r) { const int cr = (r & 3) + 8 * (r >> 2); if (cr > qh) p0[r] = -INFINITY; if (cr + 32 > qh) p1[r] = -INFINITY; } SB0(); } } while (0)
    u32x4 pc0, pc1, pc2, pc3;
    if (NT > 2) { WAIT_BAR(4); } else { WAIT_BAR(0); }
    int pend = 1 << 20; if (tid == 0) pend = (int)atomicAdd(qheads + 64 * b, 1u);
    QK8(s0); MASK(t_lo);
    { const float c0 = slope2 * (float)(64 * t_lo - q0) - smax2, c1 = c0 + s32; float rs = 0.f;
#pragma unroll
      for (int r = 0; r < 16; ++r) { p0[r] = __builtin_amdgcn_exp2f(p0[r] + c0); p1[r] = __builtin_amdgcn_exp2f(p1[r] + c1); rs += p0[r] + p1[r]; }
      l += rs;
      pc0 = (u32x4){cvtpk(p0[0], p0[1]), cvtpk(p0[2], p0[3]), cvtpk(p0[4], p0[5]), cvtpk(p0[6], p0[7])};
      pc1 = (u32x4){cvtpk(p0[8], p0[9]), cvtpk(p0[10], p0[11]), cvtpk(p0[12], p0[13]), cvtpk(p0[14], p0[15])};
      pc2 = (u32x4){cvtpk(p1[0], p1[1]), cvtpk(p1[2], p1[3]), cvtpk(p1[4], p1[5]), cvtpk(p1[6], p1[7])};
      pc3 = (u32x4){cvtpk(p1[8], p1[9]), cvtpk(p1[10], p1[11]), cvtpk(p1[12], p1[13]), cvtpk(p1[14], p1[15])}; SB0(); }
    for (int i = 0; i + 1 < NTw; ++i) {
        const int t = t_lo + i;
        if (i + 2 < NT) { WAIT_BAR(4); } else { WAIT_BAR(0); }
        {
            const int sv = (i + s0) & 3;
            KLOADS((i + 1 + s0) & 3);
            VF1 vcur, vn1; VLD1(vcur, sv, 0); VLD1(vn1, sv, 1); SB0();
            if (i + 3 < NT) DMA_TILE(t + 3, (i + 3 + s0) & 3);
            const bf16x8 q0_ = __builtin_bit_cast(bf16x8, pc0), q1_ = __builtin_bit_cast(bf16x8, pc1), q2_ = __builtin_bit_cast(bf16x8, pc2), q3_ = __builtin_bit_cast(bf16x8, pc3);
            SB0();
            QKMMA(); MASK(t + 1);
            const float c0 = slope2 * (float)(64 * (t + 1) - q0) - smax2, c1 = c0 + s32; float rs = 0.f;
            u32x4 n0, n1, n2, n3;
#pragma unroll
            for (int g = 0; g < 16; ++g) {
                VF1 vn2; if (g < 14) VLD1(vn2, sv, g + 2);
                const bf16x8 pk_ = (g & 3) == 0 ? q0_ : (g & 3) == 1 ? q1_ : (g & 3) == 2 ? q2_ : q3_;
                o[g >> 2] = MFMA32(VF8(vcur), pk_, o[g >> 2]);
                p0[g] = __builtin_amdgcn_exp2f(p0[g] + c0); p1[g] = __builtin_amdgcn_exp2f(p1[g] + c1); rs += p0[g] + p1[g];
                PINV(p0[g]); PINV(p1[g]); PINV(rs);
                if (g & 1) { const unsigned wa = cvtpk(p0[g - 1], p0[g]), wb = cvtpk(p1[g - 1], p1[g]); const int k = g >> 1;
                    if (k < 4) { n0[k & 3] = wa; n2[k & 3] = wb; } else { n1[k & 3] = wa; n3[k & 3] = wb; } }
                SB0();
                vcur = vn1; if (g < 14) vn1 = vn2;
            }
            l += rs;
            pc0 = n0; pc1 = n1; pc2 = n2; pc3 = n3;
        }
    }
    {
        const int i = NTw - 1;
        if (i + 2 < NT) { WAIT_BAR(4); } else { WAIT_BAR(0); }
        if (i + 3 < NT) DMA_TILE(t_lo + i + 3, (i + 3 + s0) & 3);
        const int sv = (i + s0) & 3;
        const bf16x8 q0_ = __builtin_bit_cast(bf16x8, pc0), q1_ = __builtin_bit_cast(bf16x8, pc1), q2_ = __builtin_bit_cast(bf16x8, pc2), q3_ = __builtin_bit_cast(bf16x8, pc3);
        VF1 vcur; VLD1(vcur, sv, 0);
#pragma unroll
        for (int g = 0; g < 16; ++g) {
            VF1 vnx; if (g < 15) VLD1(vnx, sv, g + 1);
            const bf16x8 pk_ = (g & 3) == 0 ? q0_ : (g & 3) == 1 ? q1_ : (g & 3) == 2 ? q2_ : q3_;
            o[g >> 2] = MFMA32(VF8(vcur), pk_, o[g >> 2]);
            SB0();
            if (g < 15) vcur = vnx;
        }
    }
    if (NTw < NT) { WAIT_BAR(0); }
#undef KLD
#undef VLD1
#undef VF8
#undef QK8
#undef KLOADS
#undef QKMMA
#undef MASK
#undef PINV
#undef DMA_TILE
    l = half_swap_sum(l);
    const float rl = 1.0f / l;
    if (my_tid(wave_) == 0) {
        int d_ = -1;
        if (pend < 512) d_ = (b << 16) | utab[pend];
        else for (int qi_ = ((b - xcc) & 7) + 1; qi_ < 8; ++qi_) { const int bq_ = (xcc + qi_) & 7; const int ix_ = (int)atomicAdd(qheads + 64 * bq_, 1u); if (ix_ < 512) { d_ = (bq_ << 16) | utab[ix_]; break; } }
        *nextw = d_;
    }
    WAIT_BAR(0);
    const int lane2 = my_tid(wave_) & 63, hi2 = lane2 >> 5;
    {
        const int nd = *nextw;
        if (nd >= 0) {
            const int nb = nd >> 16, nh = (nd >> 6) & 7, nqb = nd & 63, ndd = nqb * 128 - cuts[nh], ntl = ndd > 0 ? ndd >> 6 : 0, nNT = 2 * nqb + 2 - ntl;
            const bf16_t* nk = KA + (size_t)(nb * 16 + 2 * nh) * SEQ * 64 + klane + (size_t)ntl * 64 * 64;
            const bf16_t* nv = VA + (size_t)(nb * 8 + nh) * SEQ * 128 + vlane + (size_t)ntl * 64 * 128;
            const unsigned so_ = (unsigned)(s0 ^ 2) * ASLOT;
            GLDS(nk, kdst + so_); GLDS(nk + (size_t)SEQ * 64, kdst + 8192 + so_); GLDS(nv, vdstA + so_); GLDS(nv + 4 * 128, vdstB + so_);
            if (nNT > 1) { GLDS(nk + 64 * 64, kdst + so_ + ASLOT); GLDS(nk + (size_t)SEQ * 64 + 64 * 64, kdst + 8192 + so_ + ASLOT); GLDS(nv + 64 * 128, vdstA + so_ + ASLOT); GLDS(nv + 64 * 128 + 4 * 128, vdstB + so_ + ASLOT); }
            const bf16_t* Qn = QA + ((size_t)nb * SEQ + nqb * 128 + 32 * wq + (lane2 & 31)) * 1024 + (2 * nh + j) * 64 + hi2 * 8;
#pragma unroll
            for (int d0 = 0; d0 < 4; ++d0) qio[d0] = *(const bf16x8*)(Qn + d0 * 16);
        }
    }
    LAS float* xch = (LAS float*)(lds + s0 * ASLOT) + wq * 4096 + lane2;
    if (j == 1) {
#pragma unroll
        for (int db = 0; db < 4; ++db)
#pragma unroll
            for (int r = 0; r < 16; ++r) xch[(db * 16 + r) * 64] = o[db][r] * rl;
    }
    WAIT_BAR(0);
    if (j == 0) {
        float ss = 0.f;
#pragma unroll
        for (int db = 0; db < 4; ++db) {
            SB0();
#pragma unroll
            for (int r = 0; r < 16; ++r) { const float v = o[db][r] * rl - lam * xch[(db * 16 + r) * 64]; o[db][r] = v; ss += v * v; }
        }
        ss = half_swap_sum(ss);
        const float rstd = rsqrtf(ss * (1.0f / 128.0f) + 1e-6f) * 0.8f;
        const size_t rowoff = ((size_t)b * SEQ + q0 + 32 * wq + (lane2 & 31)) * 1024 + h * 128;
#pragma unroll
        for (int db = 0; db < 4; ++db) {
            SB0();
#pragma unroll
            for (int rg = 0; rg < 4; ++rg) {
                const int d = 32 * db + 8 * rg + 4 * hi2;
                const f32x4 g = *(const f32x4*)(subg + d);
                const u32x2 zz = *(const u32x2*)(ZA + rowoff + d);
                const float v0 = o[db][4 * rg + 0] * rstd * g[0] * bf_lo(zz.x), v1 = o[db][4 * rg + 1] * rstd * g[1] * bf_hi(zz.x);
                const float v2 = o[db][4 * rg + 2] * rstd * g[2] * bf_lo(zz.y), v3 = o[db][4 * rg + 3] * rstd * g[3] * bf_hi(zz.y);
                u32x2 w; w.x = cvtpk(v0, v1); w.y = cvtpk(v2, v3);
                *(u32x2*)(OA + rowoff + d) = w;
            }
        }
    }
    WAIT_BAR(0);
}

__device__ __forceinline__ void attnB_stage(const int wave_, const int lane, unsigned bufaddr, int b, int kvh, int nb, const bf16_t* KVS) {
    const int krow = 8 * wave_ + (lane >> 3), kch = (lane & 7) ^ ((krow >> 1) & 7), vch = (lane & 7) ^ (((krow >> 1) & 1) << 2);
    const long row0 = (long)b * SEQ + 128L * (nb - 1) + krow;
    const bf16_t* ksrc = KVS + row0 * 256 + kvh * 64 + kch * 8;
    const bf16_t* vsrc = KVS + row0 * 256 + 128 + kvh * 64 + vch * 8;
    for (int bt = (nb == 0 ? 2 : 0); bt < 4; ++bt) { GLDS(ksrc + (size_t)bt * 64 * 256, bufaddr + bt * 16384 + wave_ * 1024); GLDS(vsrc + (size_t)bt * 64 * 256, bufaddr + bt * 16384 + 8192 + wave_ * 1024); }
}
__device__ __forceinline__ void attnB_unit(const int wave_, LAS unsigned char* buf, int b, int kvh, int nb, float smax2,
                                           const bf16_t* QB, const bf16_t* ZB, bf16_t* OB, const float* sinks) {
    const int tid = my_tid(wave_);
    const int lane = tid & 63, r32 = lane & 31, hi = lane >> 5;
    const int hq = kvh * 8 + wave_;
    const size_t rowbase = (size_t)b * SEQ;
    const float slope2 = exp2f(-0.5f * (float)(hq + 1)) * LOG2E, sink2 = sinks[hq] * LOG2E;
    const float ref = fmaxf(smax2, sink2), psink = __builtin_amdgcn_exp2f(sink2 - ref);
    const int bt0 = nb == 0 ? 2 : 0;
    const int kx0 = r32 * 128 + (hi ^ ((r32 >> 1) & 7)) * 16;
    const int rq = (lane & 15) >> 2;
    const int vx0 = 8192 + 128 * (4 * hi + rq) + 64 * (rq >> 1) + 32 * ((lane >> 4) & 1) + 8 * (lane & 3);
    const int qh = r32 - 4 * hi;
    f32x16 biasB;
#pragma unroll
    for (int r = 0; r < 16; ++r) biasB[r] = slope2 * (float)((r & 3) + 8 * (r >> 2));
    bf16x8 qf[4], qn[4];
    { const bf16_t* Qp = QB + (rowbase + nb * 128 + r32) * 1024 + hq * 64 + hi * 8;
#pragma unroll
      for (int d0 = 0; d0 < 4; ++d0) qf[d0] = *(const bf16x8*)(Qp + d0 * 16); }
    for (int rb = 0; rb < 4; ++rb) {
        const size_t rowoff = (rowbase + nb * 128 + 32 * rb + r32) * 1024 + hq * 64;
        if (rb < 3) {
#pragma unroll
            for (int d0 = 0; d0 < 4; ++d0) qn[d0] = *(const bf16x8*)(QB + rowoff + 32 * 1024 + d0 * 16 + hi * 8);
        }
        u32x2 zz[2][4];
#pragma unroll
        for (int db = 0; db < 2; ++db)
#pragma unroll
            for (int rg = 0; rg < 4; ++rg) zz[db][rg] = *(const u32x2*)(ZB + rowoff + 32 * db + 8 * rg + 4 * hi);
        float l = hi == 0 ? psink : 0.0f;
        f32x16 o[2];
#pragma unroll
        for (int db = 0; db < 2; ++db)
#pragma unroll
            for (int r = 0; r < 16; ++r) o[db][r] = 0.f;
        for (int tt = 0; tt < 3; ++tt) {
            const int bt = (rb >> 1) + tt;
            if (bt < bt0) continue;
            const lds_cptr tb = (lds_cptr)buf + bt * 16384;
            f32x16 p0, p1;
            { bf16x8 ka[2], kb2[2], kc[2], kd[2];
              ka[0] = *(const LAS bf16x8*)(tb + kx0); ka[1] = *(const LAS bf16x8*)(tb + kx0 + 4096);
              kb2[0] = *(const LAS bf16x8*)(tb + (kx0 ^ 32)); kb2[1] = *(const LAS bf16x8*)(tb + (kx0 ^ 32) + 4096);
              kc[0] = *(const LAS bf16x8*)(tb + (kx0 ^ 64)); kc[1] = *(const LAS bf16x8*)(tb + (kx0 ^ 64) + 4096);
              kd[0] = *(const LAS bf16x8*)(tb + (kx0 ^ 96)); kd[1] = *(const LAS bf16x8*)(tb + (kx0 ^ 96) + 4096);
              __builtin_amdgcn_sched_barrier(0);
              p0 = MFMA32(ka[0], qf[0], biasB); p1 = MFMA32(ka[1], qf[0], biasB); p0 = MFMA32(kb2[0], qf[1], p0); p1 = MFMA32(kb2[1], qf[1], p1);
              p0 = MFMA32(kc[0], qf[2], p0); p1 = MFMA32(kc[1], qf[2], p1); p0 = MFMA32(kd[0], qf[3], p0); p1 = MFMA32(kd[1], qf[3], p1);
              __builtin_amdgcn_sched_barrier(0); }
            s16x4 lo_, hh_, lo1_, hh1_;
            lo_ = vtr(tb + vx0); hh_ = vtr(tb + vx0 + 1024); lo1_ = vtr(tb + vx0 + 2048); hh1_ = vtr(tb + vx0 + 2048 + 1024);
            __builtin_amdgcn_sched_barrier(0);
            const int D0 = 128 + 32 * rb - 64 * bt;
            const float c0 = -slope2 * (float)(D0 + qh) - ref, c1 = c0 + 32.f * slope2;
            float rs = 0.f;
#pragma unroll
            for (int r = 0; r < 16; ++r) { p0[r] = __builtin_amdgcn_exp2f(p0[r] + c0); p1[r] = __builtin_amdgcn_exp2f(p1[r] + c1); }
#define MASKH(P, Dn) do { if ((Dn) == 128) { _Pragma("unroll") for (int r = 0; r < 16; ++r) { const int cr = (r & 3) + 8 * (r >> 2); if (!(cr > qh)) P[r] = 0.f; } } \
                else if ((Dn) == 0) { _Pragma("unroll") for (int r = 0; r < 16; ++r) { const int cr = (r & 3) + 8 * (r >> 2); if (cr > qh) P[r] = 0.f; } } \
                else if ((Dn) < 0 || (Dn) > 128) { _Pragma("unroll") for (int r = 0; r < 16; ++r) P[r] = 0.f; } } while (0)
            MASKH(p0, D0); MASKH(p1, D0 - 32);
#undef MASKH
#pragma unroll
            for (int r = 0; r < 16; ++r) rs += p0[r] + p1[r];
            l += rs;
            bf16x8 pf[4]; pack_p(pf, p0, p1);
            __builtin_amdgcn_sched_barrier(0);
            {
                s16x4 lo2_, hh2_;
#pragma unroll
                for (int g = 0; g < 8; ++g) {
                    if (g < 6) { const int g2 = g + 2; lo2_ = vtr(tb + (vx0 ^ (64 * (g2 >> 2))) + (g2 & 3) * 2048); hh2_ = vtr(tb + (vx0 ^ (64 * (g2 >> 2))) + (g2 & 3) * 2048 + 1024); }
                    const bf16x8 vf = (bf16x8){lo_[0], lo_[1], lo_[2], lo_[3], hh_[0], hh_[1], hh_[2], hh_[3]};
                    o[g >> 2] = MFMA32(vf, pf[g & 3], o[g >> 2]);
                    __builtin_amdgcn_sched_barrier(0);
                    lo_ = lo1_; hh_ = hh1_; if (g < 6) { lo1_ = lo2_; hh1_ = hh2_; }
                }
            }
        }
        l = half_swap_sum(l);
        const float rl = 1.0f / l;
#pragma unroll
        for (int db = 0; db < 2; ++db)
#pragma unroll
            for (int rg = 0; rg < 4; ++rg) {
                const int d = 32 * db + 8 * rg + 4 * hi;
                const u32x2 z_ = zz[db][rg];
                const float v0 = o[db][4 * rg + 0] * rl * bf_lo(z_.x), v1 = o[db][4 * rg + 1] * rl * bf_hi(z_.x);
                const float v2 = o[db][4 * rg + 2] * rl * bf_lo(z_.y), v3 = o[db][4 * rg + 3] * rl * bf_hi(z_.y);
                u32x2 w; w.x = cvtpk(v0, v1); w.y = cvtpk(v2, v3);
                *(u32x2*)(OB + rowoff + d) = w;
            }
        if (rb < 3) {
#pragma unroll
            for (int d0 = 0; d0 < 4; ++d0) qf[d0] = qn[d0];
        }
    }
}

__device__ __forceinline__ int permrow(int a) { const int r = a & 255; return (a & ~255) + ((r >> 5) & 1) * 128 + (r >> 6) * 32 + (r & 31); }
__device__ __forceinline__ void p0_transpose_item(const float* W, int K, int N, bf16_t* WT, LAS float* scr, int item, int lane, const float* kgain = nullptr, const float* kscale = nullptr) {
    const int nblk = N / 32, kb = item / nblk, nb = item - kb * nblk, k0 = 64 * kb, n0 = 32 * nb;
#pragma unroll 8
    for (int i = 0; i < 32; ++i) { const int kk = 2 * i + (lane >> 5); scr[kk * 33 + (lane & 31)] = W[(size_t)(k0 + kk) * N + n0 + (lane & 31)]; }
    LDS_WAIT();
    const int c = lane & 7;
    const int prow0 = permrow(n0);
#pragma unroll
    for (int jj = 0; jj < 4; ++jj) { const int n = (lane >> 3) + 8 * jj; const LAS float* s = scr + (8 * c) * 33 + n;
        f32x4 m0 = {1.f, 1.f, 1.f, 1.f}, m1 = {1.f, 1.f, 1.f, 1.f};
        if (kgain) { m0 = *(const f32x4*)(kgain + k0 + 8 * c) * (*(const f32x4*)(kscale + k0 + 8 * c) + 1.0f); m1 = *(const f32x4*)(kgain + k0 + 8 * c + 4) * (*(const f32x4*)(kscale + k0 + 8 * c + 4) + 1.0f); }
        u32x4 o; o.x = cvtpk(s[0 * 33] * m0[0], s[1 * 33] * m0[1]); o.y = cvtpk(s[2 * 33] * m0[2], s[3 * 33] * m0[3]); o.z = cvtpk(s[4 * 33] * m1[0], s[5 * 33] * m1[1]); o.w = cvtpk(s[6 * 33] * m1[2], s[7 * 33] * m1[3]);
        *(u32x4*)(WT + (size_t)(prow0 + n) * K + k0 + 8 * c) = o; }
    LDS_WAIT();
}
template <bool TWO, bool IN_BF16> __device__ __forceinline__ void norm_chunk(const void* Xv, int chunk, int lane,
        const float* g1, const float* sh1, const float* sc1, bf16_t* out1, const float* g2, const float* sh2, const float* sc2, bf16_t* out2, float* rstd_out = nullptr) {
    f32x4 A1[4], S1[4], A2[4], S2[4];
#pragma unroll
    for (int jj = 0; jj < 4; ++jj) { const int col = 4 * lane + 256 * jj;
        A1[jj] = *(const f32x4*)(g1 + col) * (*(const f32x4*)(sc1 + col) + 1.0f); S1[jj] = *(const f32x4*)(sh1 + col);
        if (TWO) { A2[jj] = *(const f32x4*)(g2 + col) * (*(const f32x4*)(sc2 + col) + 1.0f); S2[jj] = *(const f32x4*)(sh2 + col); } }
    for (int rr = 0; rr < 32; ++rr) {
        const size_t row = (size_t)chunk * 32 + rr;
        f32x4 v[4]; float ss = 0.f;
#pragma unroll
        for (int jj = 0; jj < 4; ++jj) {
            if (IN_BF16) { const u32x2 w = *(const u32x2*)((const bf16_t*)Xv + row * 1024 + 4 * lane + 256 * jj); v[jj] = (f32x4){bf_lo(w.x), bf_hi(w.x), bf_lo(w.y), bf_hi(w.y)}; }
            else v[jj] = *(const f32x4*)((const float*)Xv + row * 1024 + 4 * lane + 256 * jj);
            ss += (v[jj][0] * v[jj][0] + v[jj][1] * v[jj][1]) + (v[jj][2] * v[jj][2] + v[jj][3] * v[jj][3]); }
        const float rstd = rsqrtf(wave_sum(ss) * (1.0f / 1024.0f) + 1e-6f);
        if (rstd_out && lane == 0) rstd_out[row] = rstd;
#pragma unroll
        for (int jj = 0; jj < 4; ++jj) {
            const f32x4 xn = v[jj] * rstd;
            if (out1) { const f32x4 u = xn * A1[jj] + S1[jj]; u32x2 w; w.x = cvtpk(u[0], u[1]); w.y = cvtpk(u[2], u[3]); *(u32x2*)(out1 + row * 1024 + 4 * lane + 256 * jj) = w; }
            if (TWO) { const f32x4 u = xn * A2[jj] + S2[jj]; u32x2 w; w.x = cvtpk(u[0], u[1]); w.y = cvtpk(u[2], u[3]); *(u32x2*)(out2 + row * 1024 + 4 * lane + 256 * jj) = w; }
        }
    }
}

struct RowOrder {
    int nM, nN, G, c;
    __device__ void init(int M, int N, int G_, int c_) { nM = M / 256; nN = N / 256; G = G_; c = c_; }
    __device__ bool next(int i, pg8::Unit& u) const { const int pm = c + (i / nN) * G; if (pm >= nM) return false; u.pm = pm; u.pn = i % nN; return true; }
    __device__ __forceinline__ void a_ready(const pg8::Unit&) const {}
    __device__ __forceinline__ void done(const pg8::Unit&) const {}
};
struct Params { const float* in[26]; float* out; unsigned char* ws; int ph_lo, ph_hi; };

__global__ void __launch_bounds__(NTHREADS) yoco_fwd(Params P) {
    extern __shared__ __attribute__((aligned(16))) unsigned char lds_raw[];
    LAS unsigned char* lds = (LAS unsigned char*)lds_raw;
    const unsigned lds0 = (unsigned)(uintptr_t)lds_raw;
    LAS unsigned char* ring = lds + 16384; const unsigned ring0 = lds0 + 16384u;
    cg::grid_group grid = cg::this_grid();
    const int wave = __builtin_amdgcn_readfirstlane(threadIdx.x >> 6);
    const int G = gridDim.x, bx = blockIdx.x;
    const int vcu = (G % 8 == 0) ? (bx % 8) * (G / 8) + bx / 8 : bx;
    const int gw = vcu * 8 + wave, NGW = G * 8;
    unsigned char* ws = P.ws;
    const float* x = P.in[0];
    float* modA = (float*)(ws + WS_MOD); float* modKV = modA + 8 * 3072; float* modB = modKV + 8 * 2048;
    float* ctlf = (float*)(ws + WS_CTL);
    bf16_t* WinA = (bf16_t*)(ws + WS_WINA); bf16_t* WoutA = (bf16_t*)(ws + WS_WOUTA); bf16_t* Wkv = (bf16_t*)(ws + WS_WKV); bf16_t* WinB = (bf16_t*)(ws + WS_WINB); bf16_t* WoutB = (bf16_t*)(ws + WS_WOUTB);
    bf16_t* R0 = (bf16_t*)(ws + WS_R0); bf16_t* R1 = (bf16_t*)(ws + WS_R1); bf16_t* R2 = (bf16_t*)(ws + WS_R2); bf16_t* R3 = (bf16_t*)(ws + WS_R3); bf16_t* R4 = (bf16_t*)(ws + WS_R4);
    float* H = (float*)(ws + WS_H);
    const int lo = P.ph_lo, hi_ = P.ph_hi;
#ifndef REP_MASK
#define REP_MASK 0
#endif
#define NREP(k) ((((REP_MASK) >> (k)) & 1) + 1)
#ifndef PH_MASK
#define PH_MASK 0x1ff
#endif
#define IN(k) (((PH_MASK >> (k)) & 1) && lo <= (k) && (k) < hi_)
    unsigned* const xbar = (unsigned*)ctlf + 4096;
    const unsigned xcc_id = (unsigned)__builtin_amdgcn_s_getreg((3 << 11) | 20) & 0xFu;
    volatile LAS unsigned* const xst = (volatile LAS unsigned*)(lds + 8192);
#define GBAR() grid_bar(xbar, xcc_id, xst, wave)
#define SEAM(k) do { if (IN(k) && IN((k) + 1)) { if ((k) == 0) { grid.sync(); if (my_tid(wave) == 0) { xst[0] = 0u; xst[1] = 0u; (void)xb_add(&xbar[XB_XCNT(xcc_id)], 1u); } } else GBAR(); } } while (0)

    if (IN(0)) {
        const int tid = my_tid(wave), lane = tid & 63;
        LAS float* sc = (LAS float*)lds;
        LAS float* red = (LAS float*)(lds + 32768);
        const float* c = P.in[1];
        for (int i = tid; i < 8192; i += NTHREADS) { const int bb = i >> 10, k = i & 1023; const float v = c[i]; sc[k * 8 + bb] = v / (1.0f + __expf(-v)); }
        __syncthreads();
        for (int cgp = bx; cgp < 256; cgp += G) {
            const int n0 = cgp * 32;
            const float* W; const float* bias; int N, nloc; float* dst;
            if (n0 < 3072) { W = P.in[3]; bias = P.in[4]; N = 3072; nloc = n0; dst = modA; }
            else if (n0 < 5120) { W = P.in[15]; bias = P.in[16]; N = 2048; nloc = n0 - 3072; dst = modKV; }
            else { W = P.in[20]; bias = P.in[21]; N = 3072; nloc = n0 - 5120; dst = modB; }
            const int col = tid & 31, ks = tid >> 5;
            f32x4 a0 = {0.f, 0.f, 0.f, 0.f}, a1 = {0.f, 0.f, 0.f, 0.f};
#pragma unroll 8
            for (int kk = 0; kk < 64; ++kk) { const int k = ks * 64 + kk; const float w = W[(size_t)k * N + nloc + col];
                const f32x4 s0 = *(const LAS f32x4*)(sc + k * 8), s1 = *(const LAS f32x4*)(sc + k * 8 + 4); a0 += s0 * w; a1 += s1 * w; }
#pragma unroll
            for (int e = 0; e < 4; ++e) { red[(ks * 8 + e) * 32 + col] = a0[e]; red[(ks * 8 + 4 + e) * 32 + col] = a1[e]; }
            __syncthreads();
            if (tid < 256) { const int bb = tid >> 5, cc = tid & 31; float s = bias[nloc + cc];
#pragma unroll
                for (int k2 = 0; k2 < 16; ++k2) s += red[(k2 * 8 + bb) * 32 + cc];
                dst[(size_t)bb * N + nloc + cc] = s; }
            __syncthreads();
        }
        if (bx == 0 && wave == 0) {
            float a = P.in[8][lane] * P.in[9][lane], bq = P.in[10][lane] * P.in[11][lane];
            a = wave_sum(a); bq = wave_sum(bq);
            if (lane == 0) ctlf[0] = __expf(a) - __expf(bq) + 0.2f;
            const float gq = P.in[6][lane], gk = P.in[7][lane];
            ctlf[64 + lane] = gq; ctlf[128 + lane] = gk;
            float mq = fabsf(gq), mk = fabsf(gk);
#pragma unroll
            for (int o_ = 1; o_ < 64; o_ <<= 1) { mq = fmaxf(mq, __shfl_xor(mq, o_)); mk = fmaxf(mk, __shfl_xor(mk, o_)); }
            const float smax2 = pg8::QK_C2 * 64.0f * mq * mk * 1.02f;
            if (lane == 0) ctlf[1] = smax2;
            { float mqb = fabsf(P.in[23][lane]), mkb = fabsf(P.in[18][lane]);
#pragma unroll
              for (int o_ = 1; o_ < 64; o_ <<= 1) { mqb = fmaxf(mqb, __shfl_xor(mqb, o_)); mkb = fmaxf(mkb, __shfl_xor(mkb, o_)); }
              if (lane == 0) ctlf[2] = pg8::QK_C2 * 64.0f * mqb * mkb * 1.02f; }
            if (lane < 8) { const float sl2 = exp2f(-(float)(lane + 1)) * LOG2E; const float cf = (2.0f * smax2 + 152.0f) / sl2;
                const int ci = cf > 1.0e6f ? 1000000 : (int)cf + 1; ((int*)ctlf)[16 + lane] = ci; ((LAS int*)(lds + 131072))[lane] = ci;
                ((unsigned*)ctlf)[256 + 64 * lane] = 0u; ((unsigned*)ctlf)[256 + 512 + 64 * lane] = 0u; }
        }
        __syncthreads();
        if (bx == 0) { for (int i_ = tid; i_ < XCD_BAR_WORDS; i_ += NTHREADS) ((unsigned*)ctlf)[4096 + i_] = 0u; }
        if (bx == 0) {
            LAS int* cuts = (LAS int*)(lds + 131072); LAS int* wk = cuts + 64;
            { const int hh = tid >> 6, qq = tid & 63, dd = qq * 128 - cuts[hh]; wk[tid] = 2 * qq + 2 - (dd > 0 ? dd >> 6 : 0); }
            __syncthreads();
            { const int mine = wk[tid]; int rank = 0;
              for (int k2 = 0; k2 < 512; ++k2) { const int wo = wk[k2]; rank += (wo > mine || (wo == mine && k2 < tid)) ? 1 : 0; }
              ((int*)ctlf)[2048 + rank] = tid; }
        }
        __syncthreads();
        LAS float* scr = (LAS float*)(lds + wave * 16384);
        constexpr int I_A = 16 * 128, I_OA = 16 * 32, I_KV = 16 * 8, I_B = 16 * 64, I_OB = 16 * 32;
        for (int it = gw; it < I_A + I_OA + I_KV + I_B + I_OB; it += NGW) {
            int r = it;
            if (r < I_A) { p0_transpose_item(P.in[5], 1024, 4096, WinA, scr, r, lane); continue; } r -= I_A;
            if (r < I_OA) { p0_transpose_item(P.in[13], 1024, 1024, WoutA, scr, r, lane); continue; } r -= I_OA;
            if (r < I_KV) { p0_transpose_item(P.in[17], 1024, 256, Wkv, scr, r, lane); continue; } r -= I_KV;
            if (r < I_B) { p0_transpose_item(P.in[22], 1024, 2048, WinB, scr, r, lane); continue; } r -= I_B;
            p0_transpose_item(P.in[25], 1024, 1024, WoutB, scr, r, lane);
        }
    }
    SEAM(0);
    bf16_t* const WkvB = (bf16_t*)(ws + 20 * MiB);
    float* const rstdH = (float*)(ws + 24 * MiB);
    float* const ckv = ctlf + 8192;
    if (IN(1)) for (int rep = 0; rep < NREP(1); ++rep) {
        if (rep) GBAR();
        const int lane = my_tid(wave) & 63;
        {
            LAS float* scr2 = (LAS float*)(ring + wave * 16384);
            for (int it = gw; it < 8 * 128; it += NGW) { const int bb = it >> 7;
                p0_transpose_item(P.in[17], 1024, 256, WkvB + (size_t)bb * 256 * 1024, scr2, it & 127, lane, P.in[14], modKV + bb * 2048 + 1024); }
            for (int d_ = gw; d_ < 2048; d_ += NGW) { const int bb = d_ >> 8, a_ = d_ & 255;
                const bf16_t* wr_ = Wkv + (size_t)permrow(a_) * 1024 + 16 * lane; const float* sh_ = modKV + bb * 2048 + 16 * lane;
                const u32x4 w0 = *(const u32x4*)wr_, w1 = *(const u32x4*)(wr_ + 8); float acc_ = 0.f;
                acc_ += bf_lo(w0.x) * sh_[0] + bf_hi(w0.x) * sh_[1] + bf_lo(w0.y) * sh_[2] + bf_hi(w0.y) * sh_[3] + bf_lo(w0.z) * sh_[4] + bf_hi(w0.z) * sh_[5] + bf_lo(w0.w) * sh_[6] + bf_hi(w0.w) * sh_[7];
                acc_ += bf_lo(w1.x) * sh_[8] + bf_hi(w1.x) * sh_[9] + bf_lo(w1.y) * sh_[10] + bf_hi(w1.y) * sh_[11] + bf_lo(w1.z) * sh_[12] + bf_hi(w1.z) * sh_[13] + bf_lo(w1.w) * sh_[14] + bf_hi(w1.w) * sh_[15];
                acc_ = wave_sum(acc_); if (lane == 0) ckv[d_] = acc_; }
        }
        for (int chunk = gw; chunk < MROWS / 32; chunk += NGW) {
            const int bb = chunk >> 8;
            norm_chunk<false, false>(x, chunk, lane, P.in[2], modA + bb * 3072, modA + bb * 3072 + 1024, R0, nullptr, nullptr, nullptr, nullptr);
        }
    }
    SEAM(1);
    if (IN(2)) for (int rep = 0; rep < NREP(2); ++rep) {
        if (rep) GBAR();
        pg8::Gemm g{R0, WinA, MROWS, 4096, 1024}; pg8::StaticOrder S; S.init(MROWS, 4096, G, bx);
        pg8::EpiProj E{R1, (size_t)(64 * MiB), ctlf + 64, 16, 1024, 0x03201102};
        pg8::gemm_phase<pg8::EpiProj, pg8::StaticOrder, true, true>(ring, g, S, E, wave);
    }
    SEAM(2);
    if (IN(3)) for (int rep = 0; rep < NREP(3); ++rep) {
        if (rep) GBAR();
        const float lam = ctlf[0], smax2 = ctlf[1];
        const int* ctli = (const int*)ctlf; unsigned* qheads = (unsigned*)ctlf + 256 + 512 * rep;
        LAS int* misc = (LAS int*)lds;
        const int xcc = (int)(__builtin_amdgcn_s_getreg((3 << 11) | 20) & 7u);
        { const int t0_ = my_tid(wave); if (t0_ < 8) misc[8 + t0_] = ctli[16 + t0_]; misc[64 + t0_] = ctli[2048 + t0_];
          if (t0_ == 0) { int d_ = -1; for (int qi_ = 0; qi_ < 8; ++qi_) { const int bq_ = (xcc + qi_) & 7; const int ix_ = (int)atomicAdd(qheads + 64 * bq_, 1u); if (ix_ < 512) { d_ = (bq_ << 16) | ctli[2048 + ix_]; break; } } misc[1] = d_; } }
        __syncthreads();
        int cur = misc[1], par = 0, s0 = 0, pre = 0;
        bf16x8 qio[4];
#pragma unroll
        for (int k = 0; k < 4; ++k) qio[k] = (bf16x8){0, 0, 0, 0, 0, 0, 0, 0};
        while (cur >= 0) {
            const int bq = cur >> 16, h = (cur >> 6) & 7, qb = cur & 63, dd = qb * 128 - misc[8 + h];
            attnA_unit(wave, ring, ring0, s0, pre, misc + 1 + (par ^ 1), misc + 8, misc + 64, qheads, xcc, qio, bq, h, qb, dd > 0 ? dd >> 6 : 0, smax2, R1, R2, R3, R4, R0, P.in[12], lam);
            cur = misc[1 + (par ^ 1)];
            par ^= 1; s0 ^= 2; pre = 1;
        }
    }
    SEAM(3);
    if (IN(4)) for (int rep = 0; rep < NREP(4); ++rep) {
        if (rep) GBAR();
        pg8::Gemm g{R0, WoutA, MROWS, 1024, 1024}; RowOrder S; S.init(MROWS, 1024, G, bx);
        pg8::EpiRes<false, true> E{x, (void*)H, modA + 2048, 3072};
        pg8::gemm_phase<pg8::EpiRes<false, true>, RowOrder, true, true>(ring, g, S, E, wave);
    }
    if (IN(5)) {
        asm volatile("s_waitcnt vmcnt(0)" ::: "memory"); __threadfence_block(); __syncthreads();
        bf16_t* UKVb = (bf16_t*)(ws + WS_H + 128 * MiB);
        const int lane = my_tid(wave) & 63;
        for (int pm = bx; pm < MROWS / 256; pm += G) {
            const int chunk = pm * 8 + wave, bb = chunk >> 8;
            norm_chunk<true, true>(H, chunk, lane, P.in[14], modKV + bb * 2048, modKV + bb * 2048 + 1024, nullptr, P.in[19], modB + bb * 3072, modB + bb * 3072 + 1024, R1, rstdH);
        }
        asm volatile("s_waitcnt vmcnt(0)" ::: "memory"); __threadfence_block(); __syncthreads();
        { pg8::Gemm g{(const bf16_t*)H, WkvB, MROWS, 256, 1024, (size_t)256 * 1024}; RowOrder S; S.init(MROWS, 256, G, bx);
          pg8::EpiProjT<true> E{R4, (size_t)128, P.in[18], 2, 256, 0x00000001, rstdH, ckv, 256};
          pg8::gemm_phase<pg8::EpiProjT<true>, RowOrder, true, true>(ring, g, S, E, wave); }
    }
    SEAM(5);
    if (IN(6)) for (int rep = 0; rep < NREP(6); ++rep) {
        if (rep) GBAR();
        { pg8::Gemm g{R1, WinB, MROWS, 2048, 1024}; pg8::StaticOrder S; S.init(MROWS, 2048, G, bx);
          pg8::EpiProj E{R2, (size_t)(64 * MiB), P.in[23], 16, 1024, 0x00000302};
          pg8::gemm_phase<pg8::EpiProj, pg8::StaticOrder, true, true>(ring, g, S, E, wave); }
    }
    SEAM(6);
    if (IN(7)) for (int rep = 0; rep < NREP(7); ++rep) {
        if (rep) GBAR();
        {
            const float smax2B = ctlf[2];
            const int lane_ = my_tid(wave) & 63;
            int u = vcu, par = 0;
            if (u < 1024) attnB_stage(wave, lane_, ring0, u >> 7, (u >> 6) & 1, u & 63, R4);
            for (; u < 1024; u += G, par ^= 1) {
                WAIT_BAR(0);
                if (u + G < 1024) { const int u2 = u + G; attnB_stage(wave, my_tid(wave) & 63, ring0 + (par ^ 1) * 65536u, u2 >> 7, (u2 >> 6) & 1, u2 & 63, R4); }
                attnB_unit(wave, ring + par * 65536, u >> 7, (u >> 6) & 1, u & 63, smax2B, R2, R3, R1, P.in[24]);
            }
            WAIT_BAR(0);
        }
    }
    SEAM(7);
    if (IN(8)) {
        pg8::Gemm g{R1, WoutB, MROWS, 1024, 1024}; pg8::StaticOrder S; S.init(MROWS, 1024, G, bx);
        pg8::EpiRes<true, false> E{H, P.out, modB + 2048, 3072};
        pg8::gemm_phase<pg8::EpiRes<true, false>, pg8::StaticOrder, true, true>(ring, g, S, E, wave);
    }
#undef IN
#undef SEAM
}

extern "C" void kernel_launch(void* const* d_in, const int* in_sizes, int n_in, void* d_out, int out_size, void* d_ws, size_t ws_size, hipStream_t stream) {
    static int grid = 0;
    if (grid == 0) {
        if (n_in != 26 || out_size != MROWS * DM || ws_size < WS_END) { fprintf(stderr, "kernel_launch: unexpected shapes (n_in %d out %d ws %zu)\n", n_in, out_size, ws_size); grid = -1; return; }
        int dev = 0, cus = 0, per_cu = 0;
        hipGetDevice(&dev); hipDeviceGetAttribute(&cus, hipDeviceAttributeMultiprocessorCount, dev);
        hipFuncSetAttribute((const void*)yoco_fwd, hipFuncAttributeMaxDynamicSharedMemorySize, LDS_BYTES);
        if (hipOccupancyMaxActiveBlocksPerMultiprocessor(&per_cu, (const void*)yoco_fwd, NTHREADS, LDS_BYTES) != hipSuccess || per_cu < 1) { fprintf(stderr, "kernel_launch: occupancy query gave %d\n", per_cu); per_cu = 1; }
        (void)hipGetLastError();
        grid = cus * per_cu;
    }
    if (grid < 0) return;
    Params p{};
    for (int i = 0; i < 26; ++i) p.in[i] = (const float*)d_in[i];
    p.out = (float*)d_out; p.ws = (unsigned char*)d_ws; p.ph_lo = 0; p.ph_hi = 9;
    void* args[] = {&p};
    hipError_t e = hipLaunchCooperativeKernel((const void*)yoco_fwd, dim3(grid), dim3(NTHREADS), args, LDS_BYTES, stream);
    if (e != hipSuccess) fprintf(stderr, "cooperative launch failed: %s (grid %d)\n", hipGetErrorString(e), grid);
}
```
